# Optimizing an MI355X kernel written in HIP

```python
import math
import jax, jax.numpy as jnp
from jax import lax
import numpy as np

D_MODEL = 4096
BATCH = 1
SEQ = 16384
DEPTH = 2

CHUNK = 64

D_MIX = D_MODEL // 2
D_SB = D_MIX // 2
SB_HEAD_DIM = 128
SB_HEADS = D_SB // SB_HEAD_DIM
SB_Q_BLOCK = 128
D_SSM = D_MIX - D_SB
SSM_GROUP = 16
SSM_GROUPS = D_SSM // SSM_GROUP
SSM_STATE = 64
D_IN = 3 * D_SB + D_SSM
DT_MIN = 1e-3
DT_MAX = 1e-1

D_FF = 6144
N_EXPERTS = 8
TOP_K = 2
D_FF_EXPERT = D_FF // 2
MOE_BLOCK = 512
N_DENSE = (DEPTH + 1) // 2
N_MOE = DEPTH // 2

RMS_EPS = 1e-6

kernel_name = "hymba_stickbreak_s5_moe_sandwich"


def rmsnorm(x, gain):
    xf = x.astype(jnp.float32)
    y = xf * lax.rsqrt(jnp.mean(xf * xf, axis=-1, keepdims=True) + RMS_EPS)
    return (y * gain.astype(jnp.float32)).astype(x.dtype)


def swiglu(x, w_gate, w_up, w_down):
    return (jax.nn.silu(x @ w_gate) * (x @ w_up)) @ w_down


def stick_breaking_attention(q, k, v):
    bsz, s, h, dh = q.shape
    n_blocks = s // SB_Q_BLOCK
    scale = dh ** -0.5
    ar = jnp.arange(SB_Q_BLOCK)
    tri_incl = (ar[:, None] >= ar[None, :]).astype(jnp.float32)
    outs = []
    for i in range(n_blocks):
        start = i * SB_Q_BLOCK
        kv_len = start + SB_Q_BLOCK
        q_blk = q[:, start:kv_len]
        k_blk = k[:, :kv_len]
        v_blk = v[:, :kv_len]
        z = jnp.einsum('bqhd,bkhd->bhqk', q_blk, k_blk,
                       preferred_element_type=jnp.float32) * scale
        q_pos = start + ar
        strict = jnp.arange(kv_len)[None, :] < q_pos[:, None]
        log_not_beta = jnp.where(strict, jax.nn.log_sigmoid(-z), 0.0)
        lnb = log_not_beta.reshape(bsz, h, SB_Q_BLOCK, i + 1, SB_Q_BLOCK)
        within = jnp.einsum('bhqnc,cd->bhqnd', lnb, tri_incl,
                            precision=lax.Precision.HIGHEST)
        nb_ar = jnp.arange(i + 1)
        later = (nb_ar[:, None] > nb_ar[None, :]).astype(jnp.float32)
        suffix = jnp.einsum('bhqn,nm->bhqm', jnp.sum(lnb, axis=-1), later,
                            precision=lax.Precision.HIGHEST)
        incl = (within + suffix[..., None]).reshape(z.shape)
        weights = jnp.where(strict,
                            jnp.exp(jax.nn.log_sigmoid(z) + incl - log_not_beta), 0.0)
        outs.append(jnp.einsum('bhqk,bkhd->bqhd', weights.astype(v.dtype), v_blk))
    out = jnp.concatenate(outs, axis=1)
    return out.reshape(bsz, s, h * dh)


def s5_ssm(u, lam_re, lam_im, log_step, b_re, b_im, c_re, c_im, d):
    f32 = jnp.float32
    bsz, s, _ = u.shape
    uf = u.astype(f32).reshape(bsz, s, SSM_GROUPS, SSM_GROUP)
    lr = jnp.minimum(lam_re.astype(f32), -1e-4)
    li = lam_im.astype(f32)
    dt = jnp.exp(log_step.astype(f32))[:, None]
    mag = jnp.exp(lr * dt)
    lb_re = mag * jnp.cos(li * dt)
    lb_im = mag * jnp.sin(li * dt)
    den = lr * lr + li * li
    nr = lb_re - 1.0
    ni = lb_im
    f_re = (nr * lr + ni * li) / den
    f_im = (ni * lr - nr * li) / den
    br = b_re.astype(f32)
    bi = b_im.astype(f32)
    bb_re = f_re[..., None] * br - f_im[..., None] * bi
    bb_im = f_re[..., None] * bi + f_im[..., None] * br
    x_re = jnp.einsum('bsgh,gph->bsgp', uf, bb_re)
    x_im = jnp.einsum('bsgh,gph->bsgp', uf, bb_im)
    a_re = jnp.broadcast_to(lb_re, x_re.shape)
    a_im = jnp.broadcast_to(lb_im, x_im.shape)

    def combine(e1, e2):
        a1r, a1i, b1r, b1i = e1
        a2r, a2i, b2r, b2i = e2
        return (a2r * a1r - a2i * a1i,
                a2r * a1i + a2i * a1r,
                a2r * b1r - a2i * b1i + b2r,
                a2r * b1i + a2i * b1r + b2i)

    _, _, h_re, h_im = lax.associative_scan(combine, (a_re, a_im, x_re, x_im), axis=1)
    y = (jnp.einsum('bsgp,ghp->bsgh', h_re, c_re.astype(f32))
         - jnp.einsum('bsgp,ghp->bsgh', h_im, c_im.astype(f32)))
    y = y + d.astype(f32).reshape(SSM_GROUPS, SSM_GROUP) * uf
    return y.reshape(bsz, s, D_SSM)


def hybrid_mixer(hn, w_in, lam_re, lam_im, log_step, b_re, b_im, c_re, c_im, d,
                 w_glu, b_glu, attn_out_norm, ssm_out_norm, w_out):
    bsz, s, _ = hn.shape
    proj = hn @ w_in
    q = proj[..., :D_SB].reshape(bsz, s, SB_HEADS, SB_HEAD_DIM)
    k = proj[..., D_SB:2 * D_SB].reshape(bsz, s, SB_HEADS, SB_HEAD_DIM)
    v = proj[..., 2 * D_SB:3 * D_SB].reshape(bsz, s, SB_HEADS, SB_HEAD_DIM)
    u = proj[..., 3 * D_SB:]

    attn = stick_breaking_attention(q, k, v)

    y = jax.nn.gelu(s5_ssm(u, lam_re, lam_im, log_step, b_re, b_im, c_re, c_im, d))
    ssm = y * jax.nn.sigmoid(y @ w_glu.astype(jnp.float32) + b_glu.astype(jnp.float32))
    ssm = ssm.astype(hn.dtype)

    merged = jnp.concatenate([rmsnorm(attn, attn_out_norm),
                              rmsnorm(ssm, ssm_out_norm)], axis=-1)
    return merged @ w_out


def moe_swiglu(h, router, w_gate, w_up, w_down):
    bsz, s, dm = h.shape
    t = bsz * s
    hf = h.reshape(t, dm)
    logits = jnp.dot(hf, router, preferred_element_type=jnp.float32)
    top_logit, top_idx = lax.top_k(logits, TOP_K)
    gates = jax.nn.softmax(top_logit, axis=-1)

    flat_e = top_idx.reshape(-1).astype(jnp.int32)
    flat_tok = jnp.repeat(jnp.arange(t, dtype=jnp.int32), TOP_K)
    flat_gate = gates.reshape(-1)
    order = jnp.argsort(flat_e)
    sorted_e = flat_e[order]
    sorted_tok = flat_tok[order]
    sorted_gate = flat_gate[order]

    counts = jnp.zeros((N_EXPERTS,), jnp.int32).at[flat_e].add(1)
    padded = (counts + MOE_BLOCK - 1) // MOE_BLOCK * MOE_BLOCK
    start = jnp.cumsum(counts) - counts
    pstart = jnp.cumsum(padded) - padded
    pend = pstart + padded
    dest = pstart[sorted_e] + jnp.arange(t * TOP_K, dtype=jnp.int32) - start[sorted_e]

    n_rows = t * TOP_K + N_EXPERTS * MOE_BLOCK
    n_blocks = n_rows // MOE_BLOCK
    row_tok = jnp.zeros((n_rows,), jnp.int32).at[dest].set(sorted_tok)
    row_gate = jnp.zeros((n_rows,), jnp.float32).at[dest].set(sorted_gate)
    blk_start = jnp.arange(n_blocks, dtype=jnp.int32) * MOE_BLOCK
    blk_expert = jnp.minimum(jnp.sum(blk_start[:, None] >= pend[None, :], axis=1),
                             N_EXPERTS - 1)

    def run_block(args):
        tok, e = args
        return swiglu(hf[tok], w_gate[e], w_up[e], w_down[e])

    y_rows = lax.map(run_block, (row_tok.reshape(n_blocks, MOE_BLOCK), blk_expert))
    y_rows = y_rows.reshape(n_rows, dm) * row_gate[:, None].astype(h.dtype)
    out = jax.ops.segment_sum(y_rows, row_tok, num_segments=t)
    return out.reshape(bsz, s, dm)


def setup_inputs(seed: int = 0) -> dict:
    key = jax.random.key(seed)
    ks = jax.random.split(key, 26)
    f32 = jnp.float32

    def nrm(k, shape, fan_in):
        return jax.random.normal(k, shape, f32) * (fan_in ** -0.5)

    def gain(k, shape):
        return 1.0 + 0.02 * jax.random.normal(k, shape, f32)

    n_idx = jnp.arange(SSM_STATE, dtype=f32)
    return {
        "x": jax.random.normal(ks[0], (BATCH, SEQ, D_MODEL), f32),
        "attn_pre_norm": gain(ks[1], (DEPTH, D_MODEL)),
        "attn_post_norm": gain(ks[2], (DEPTH, D_MODEL)),
        "ffn_pre_norm": gain(ks[3], (DEPTH, D_MODEL)),
        "ffn_post_norm": gain(ks[4], (DEPTH, D_MODEL)),
        "w_in": nrm(ks[5], (DEPTH, D_MODEL, D_IN), D_MODEL),
        "ssm_lambda_re": -0.5 + 0.01 * jax.random.normal(ks[6], (DEPTH, SSM_GROUPS, SSM_STATE), f32),
        "ssm_lambda_im": math.pi * n_idx + 0.01 * jax.random.normal(ks[7], (DEPTH, SSM_GROUPS, SSM_STATE), f32),
        "ssm_log_step": jax.random.uniform(ks[8], (DEPTH, SSM_GROUPS), f32,
                                           minval=math.log(DT_MIN), maxval=math.log(DT_MAX)),
        "ssm_b_re": nrm(ks[9], (DEPTH, SSM_GROUPS, SSM_STATE, SSM_GROUP), 2 * SSM_GROUP),
        "ssm_b_im": nrm(ks[10], (DEPTH, SSM_GROUPS, SSM_STATE, SSM_GROUP), 2 * SSM_GROUP),
        "ssm_c_re": nrm(ks[11], (DEPTH, SSM_GROUPS, SSM_GROUP, SSM_STATE), 2 * SSM_STATE),
        "ssm_c_im": nrm(ks[12], (DEPTH, SSM_GROUPS, SSM_GROUP, SSM_STATE), 2 * SSM_STATE),
        "ssm_d": jax.random.normal(ks[13], (DEPTH, D_SSM), f32),
        "w_glu": nrm(ks[14], (DEPTH, D_SSM, D_SSM), D_SSM),
        "b_glu": 0.02 * jax.random.normal(ks[15], (DEPTH, D_SSM), f32),
        "attn_out_norm": gain(ks[16], (DEPTH, D_SB)),
        "ssm_out_norm": gain(ks[17], (DEPTH, D_SSM)),
        "w_out": nrm(ks[18], (DEPTH, D_MIX, D_MODEL), D_MIX),
        "ffn_w_gate": nrm(ks[19], (N_DENSE, D_MODEL, D_FF), D_MODEL),
        "ffn_w_up": nrm(ks[20], (N_DENSE, D_MODEL, D_FF), D_MODEL),
        "ffn_w_down": nrm(ks[21], (N_DENSE, D_FF, D_MODEL), D_FF),
        "moe_router": nrm(ks[22], (N_MOE, D_MODEL, N_EXPERTS), D_MODEL),
        "moe_w_gate": nrm(ks[23], (N_MOE, N_EXPERTS, D_MODEL, D_FF_EXPERT), D_MODEL),
        "moe_w_up": nrm(ks[24], (N_MOE, N_EXPERTS, D_MODEL, D_FF_EXPERT), D_MODEL),
        "moe_w_down": nrm(ks[25], (N_MOE, N_EXPERTS, D_FF_EXPERT, D_MODEL), D_FF_EXPERT),
    }


def reference(x, attn_pre_norm, attn_post_norm, ffn_pre_norm, ffn_post_norm, w_in,
              ssm_lambda_re, ssm_lambda_im, ssm_log_step, ssm_b_re, ssm_b_im,
              ssm_c_re, ssm_c_im, ssm_d, w_glu, b_glu, attn_out_norm, ssm_out_norm,
              w_out, ffn_w_gate, ffn_w_up, ffn_w_down, moe_router, moe_w_gate,
              moe_w_up, moe_w_down):
    h = x
    for layer in range(DEPTH):
        mixed = hybrid_mixer(rmsnorm(h, attn_pre_norm[layer]), w_in[layer],
                             ssm_lambda_re[layer], ssm_lambda_im[layer], ssm_log_step[layer],
                             ssm_b_re[layer], ssm_b_im[layer], ssm_c_re[layer], ssm_c_im[layer],
                             ssm_d[layer], w_glu[layer], b_glu[layer],
                             attn_out_norm[layer], ssm_out_norm[layer], w_out[layer])
        h = h + rmsnorm(mixed, attn_post_norm[layer])
        hn = rmsnorm(h, ffn_pre_norm[layer])
        i = layer // 2
        if layer % 2 == 0:
            f = swiglu(hn, ffn_w_gate[i], ffn_w_up[i], ffn_w_down[i])
        else:
            f = moe_swiglu(hn, moe_router[i], moe_w_gate[i], moe_w_up[i], moe_w_down[i])
        h = h + rmsnorm(f, ffn_post_norm[layer])
    return h
```

```cpp
#include <hip/hip_runtime.h>
#include <cstdio>
#include <cstdint>

#define GAS __attribute__((address_space(1)))
#define LAS __attribute__((address_space(3)))
typedef unsigned short bf16;
typedef short bf16x8 __attribute__((ext_vector_type(8)));
typedef short s16x4 __attribute__((ext_vector_type(4)));
typedef float f32x2 __attribute__((ext_vector_type(2)));
typedef float f32x4 __attribute__((ext_vector_type(4)));
typedef float f32x16 __attribute__((ext_vector_type(16)));
typedef unsigned u32x2 __attribute__((ext_vector_type(2)));
typedef unsigned u32x4 __attribute__((ext_vector_type(4)));
typedef int i32x2 __attribute__((ext_vector_type(2)));
typedef int i32x4 __attribute__((ext_vector_type(4)));

#ifndef DENSE_DOWN_F8
#define DENSE_DOWN_F8 1
#endif
#ifndef GU8_TILES
#define GU8_TILES 48
#endif
#define DENSE_GU_F8 (GU8_TILES > 0)
#ifndef GU8_ASCALE
#define GU8_ASCALE 1.0f
#endif
#ifndef GU8_WSCALE
#define GU8_WSCALE 1.0f
#endif
#ifndef SPEC_ATT
#define SPEC_ATT 128
#endif
#ifndef MOE_Y8
#define MOE_Y8 1
#endif
#ifndef MERGE_FUSED
#define MERGE_FUSED 1
#endif
#ifndef WIN8_TILES
#define WIN8_TILES 0
#endif
constexpr int T_ = 16384, DM = 4096, DIN = 4096, DSB = 1024, DSSM = 1024, DMIX = 2048, DFF = 6144, NE = 8, DFE = 3072;
constexpr int NH = 8, NG = 64, SP = 64, LCH = 16, NCH = T_ / LCH;
constexpr float RMS_EPS = 1e-6f;
constexpr float QSCALE = 0.08838834764831845f * 1.4426950408889634f;
constexpr int LIST_CAP = 16384;
constexpr int MOE_MAXROWS = 34816;

constexpr size_t MiB = 1u << 20;
constexpr size_t WS_CTL = 0, CTL_ZERO_BYTES = 131072 + 262144;
constexpr size_t WS_SS = 131072;
constexpr size_t WS_LIST = 1 * MiB;
constexpr size_t WS_POS = 2 * MiB;
constexpr size_t WS_RS = 2 * MiB + 512 * 1024;
constexpr size_t WS_SSMAUX = 3 * MiB;
constexpr size_t WS_SSMW = 4 * MiB;
constexpr size_t WS_SSMTM = 12 * MiB;
constexpr size_t WS_SST = 36 * MiB;
constexpr size_t WS_WIN = 68 * MiB;
constexpr size_t WS_WGLU = 132 * MiB;
constexpr size_t WS_WOUT = 136 * MiB;
constexpr size_t WS_FGU = 168 * MiB;
constexpr size_t WS_FDN = 264 * MiB;
constexpr size_t WS_MGU = 312 * MiB;
constexpr size_t WS_MDN = 696 * MiB;
constexpr size_t WS_HN = 888 * MiB;
constexpr size_t WS_PROJ = 1016 * MiB;
constexpr size_t WS_ATTO = 1144 * MiB;
constexpr size_t WS_Y = 1176 * MiB;
constexpr size_t WS_SSMO = 1208 * MiB;
constexpr size_t WS_MERGED = 1240 * MiB;
constexpr size_t WS_MIXED = 1304 * MiB;
constexpr size_t WS_HID = 1432 * MiB;
constexpr size_t WS_END = 1636 * MiB;
constexpr size_t WS_H8W = WS_MERGED;
constexpr size_t WS_H8 = WS_PROJ;
constexpr size_t WS_YROWS = WS_PROJ;
static_assert(WS_YROWS + (size_t)MOE_MAXROWS * DM * 2 <= WS_MIXED, "y_rows overlay");
static_assert(WS_HID + (size_t)MOE_MAXROWS * DFE * 2 <= WS_END && WS_HID + (size_t)T_ * DFF * 2 <= WS_END, "hidden");
constexpr int CW_KMAX = 64;
constexpr int CW_CUR = 256;
constexpr int CW_BAR = 4096;

constexpr int LDS_MAIN = 0;
constexpr int LDS_MISC = 139264;
constexpr int LDS_BYTES = 147456;
constexpr int NWAVES = 8;

#define LDS_WAIT() asm volatile("s_waitcnt lgkmcnt(0)" ::: "memory")
#define VM_WAIT() asm volatile("s_waitcnt vmcnt(0)" ::: "memory")
#define RLX_AGENT __ATOMIC_RELAXED, __HIP_MEMORY_SCOPE_AGENT

__device__ __forceinline__ unsigned cvt_pk_bf16(float lo, float hi) { unsigned r; asm volatile("v_cvt_pk_bf16_f32 %0, %1, %2" : "=v"(r) : "v"(lo), "v"(hi)); return r; }
__device__ __forceinline__ unsigned cvt4_fp8(float a, float b, float c, float d) {
    unsigned w = 0u; w = (unsigned)__builtin_amdgcn_cvt_pk_fp8_f32(a, b, (int)w, false); w = (unsigned)__builtin_amdgcn_cvt_pk_fp8_f32(c, d, (int)w, true); return w; }
typedef unsigned ssq_t;
__device__ __forceinline__ ssq_t ss_fix(float s) { return (ssq_t)(s * 4096.0f + 0.5f); }
__device__ __forceinline__ float ss_rs(ssq_t v) { return rsqrtf((float)v * (1.0f / 4096.0f) * (1.0f / 1024.0f) + 1e-6f); }
__device__ __forceinline__ int lane_now() { int l; asm volatile("v_mbcnt_lo_u32_b32 %0, -1, 0\n\tv_mbcnt_hi_u32_b32 %0, -1, %0" : "=v"(l)); return l; }
__device__ __forceinline__ float bf_lo(unsigned w) { return __uint_as_float(w << 16); }
__device__ __forceinline__ float bf_hi(unsigned w) { return __uint_as_float(w & 0xffff0000u); }
__device__ __forceinline__ float wave_sum(float v) {
#pragma unroll
    for (int o = 1; o < 64; o <<= 1) v += __shfl_xor(v, o);
    return v;
}
__device__ __forceinline__ float wave_max(float v) {
#pragma unroll
    for (int o = 1; o < 64; o <<= 1) v = fmaxf(v, __shfl_xor(v, o));
    return v;
}
__device__ __forceinline__ float fast_sigmoid(float x) { return __builtin_amdgcn_rcpf(1.0f + __builtin_amdgcn_exp2f(-1.4426950408889634f * x)); }

namespace pg8 {
constexpr int BM = 256, BK = 64, HALF = 128, HTB = HALF * BK * 2, STAGE_BYTES = 8 * HTB, NXCD = 8, WGM = 4;
__host__ __device__ __forceinline__ int lds_byte(int r, int c) { const int st = (r >> 4) * 2 + (c >> 5), rr = r & 15, cc = c & 31, ob = rr * 64 + cc * 2; return st * 1024 + (ob ^ (((ob >> 9) & 1) << 5)); }
__host__ __device__ __forceinline__ void stage_rc(int b, int& R, int& C) { const int st = b / 1024, sb = b % 1024, swz = sb ^ (((sb >> 9) & 1) << 5); R = (st >> 1) * 16 + swz / 64; C = (st & 1) * 32 + (swz % 64) / 2; }
__host__ __device__ __forceinline__ int lds_byte8(int r, int c) { const int st = (r >> 4) * 2 + (c >> 5), rr = r & 15, cc = c & 31, ob = rr * 64 + cc * 2; return st * 1024 + (ob ^ (((ob >> 9) & 1) << 4)); }
__host__ __device__ __forceinline__ void stage_rc8(int b, int& R, int& C) { const int st = b / 1024, sb = b % 1024, swz = sb ^ (((sb >> 9) & 1) << 4); R = (st >> 1) * 16 + swz / 64; C = (st & 1) * 32 + (swz % 64) / 2; }
__host__ __device__ __forceinline__ int perm32(int rho) { const int n = rho >> 4, i = rho & 15; return 8 * (i >> 2) + 4 * n + (i & 3); }

struct Unit { int pm, pn; const char* A; const char* B; const i32x2* lst; int nvalid; const char* A2; };

__device__ __forceinline__ bool tile_of(long L, int nM, int nN, int& pm, int& pn) {
    const int nwg = nM * nN; if (L >= nwg) return false;
    int wgid = (int)L; { const int q = nwg / NXCD, r = nwg % NXCD, xcd = wgid % NXCD, off = wgid / NXCD; wgid = (xcd < r ? xcd * (q + 1) : r * (q + 1) + (xcd - r) * q) + off; }
    const int nig = WGM * nN, gid = wgid / nig, fm = gid * WGM, gsz = (nM - fm) < WGM ? (nM - fm) : WGM;
    pm = fm + ((wgid % nig) % gsz); pn = (wgid % nig) / gsz; return true;
}
struct DenseOrder {
    int nM, nN, G, c; const char* A; const char* B; size_t tstepA, tstepB; const char* A2 = nullptr;
    __device__ __forceinline__ void init(int M, int N, int K, int G_, int c_, const void* A_, const void* B_) { nM = M / BM; nN = N / BM; G = G_; c = c_; A = (const char*)A_; B = (const char*)B_; tstepA = tstepB = (size_t)BM * K * 2; }
    __device__ __forceinline__ bool next(int i, Unit& u) const {
        if (!tile_of((long)i * G + c, nM, nN, u.pm, u.pn)) return false;
        u.A = A + (size_t)u.pm * tstepA; u.A2 = A2 + (size_t)u.pm * tstepA; u.B = B + (size_t)u.pn * tstepB; u.lst = nullptr; u.nvalid = BM; return true; }
};
struct MoeOrder {
    int nM, nN, G, c; const LAS i32x4* tab; const char* A; const char* B; size_t tstepA, tstepB, estrideB; const i32x2* list; bool gather;
    __device__ __forceinline__ bool next(int i, Unit& u) const {
        if (!tile_of((long)i * G + c, nM, nN, u.pm, u.pn)) return false;
        const i32x4 t = tab[u.pm];
        const int e = __builtin_amdgcn_readfirstlane(t.x), slot0 = __builtin_amdgcn_readfirstlane(t.y);
        u.nvalid = __builtin_amdgcn_readfirstlane(t.z);
        u.lst = list + (size_t)e * LIST_CAP + slot0;
        u.A = gather ? A : A + (size_t)u.pm * tstepA; u.A2 = nullptr; u.B = B + (size_t)e * estrideB + (size_t)u.pn * tstepB; return true; }
};

struct EpiStore {
    static constexpr bool PERM = true; static constexpr bool KSPLIT = false;
    bf16* O; int ldc; unsigned* kmax; int kpn_lo, kpn_hi; const float* rs;
    __device__ __forceinline__ void operator()(const f32x4 (&acc)[2][2][4][2], const Unit& u, int wr, int wc, int fr, int fq) const {
        const int row0 = u.pm * BM + wr * 64 + fr, col0 = u.pn * BM + wc * 32 + 8 * fq;
        float mx = 0.f;
        float scv[2][4];
#pragma unroll
        for (int ai = 0; ai < 2; ++ai)
#pragma unroll
            for (int m = 0; m < 4; ++m) scv[ai][m] = rs ? rs[row0 + ai * HALF + m * 16] : 1.0f;
        __builtin_amdgcn_sched_barrier(0);
#pragma unroll
        for (int ai = 0; ai < 2; ++ai)
#pragma unroll
            for (int m = 0; m < 4; ++m) { const int row = row0 + ai * HALF + m * 16; bf16* rowp = O + (size_t)row * ldc + col0; const float sc = scv[ai][m];
#pragma unroll
                for (int bj = 0; bj < 2; ++bj) { const f32x4 v0 = acc[ai][bj][m][0] * sc, v1 = acc[ai][bj][m][1] * sc;
                    mx = fmaxf(mx, fmaxf(fmaxf(fmaxf(fabsf(v0[0]), fabsf(v0[1])), fmaxf(fabsf(v0[2]), fabsf(v0[3]))), fmaxf(fmaxf(fabsf(v1[0]), fabsf(v1[1])), fmaxf(fabsf(v1[2]), fabsf(v1[3])))));
                    u32x4 w; w.x = cvt_pk_bf16(v0[0], v0[1]); w.y = cvt_pk_bf16(v0[2], v0[3]); w.z = cvt_pk_bf16(v1[0], v1[1]); w.w = cvt_pk_bf16(v1[2], v1[3]);
                    *(u32x4*)(rowp + bj * HALF) = w; } }
        if (kmax != nullptr && u.pn >= kpn_lo && u.pn < kpn_hi) {
            mx = wave_max(mx);
            if (lane_now() == 0) __hip_atomic_fetch_max(kmax, __float_as_uint(mx), RLX_AGENT);
        }
    }
};
struct EpiStoreKS {
    static constexpr bool PERM = true; static constexpr bool KSPLIT = true;
    bf16* O; int ldc; const ssq_t* ssa; const ssq_t* sss;
    __device__ __forceinline__ void ratios(float (&rat)[2][4], const Unit& u, int wr, int fr) const {
        const __amdgpu_buffer_rsrc_t ra = __builtin_amdgcn_make_buffer_rsrc(const_cast<ssq_t*>(ssa), 0, T_ * 4, 0x00020000), rb = __builtin_amdgcn_make_buffer_rsrc(const_cast<ssq_t*>(sss), 0, T_ * 4, 0x00020000);
        const int vo = (wr * 64 + fr) * 4, so = u.pm * BM * 4;
#pragma unroll
        for (int ai = 0; ai < 2; ++ai)
#pragma unroll
            for (int m = 0; m < 4; ++m) { const ssq_t a = (ssq_t)__builtin_amdgcn_raw_buffer_load_b32(ra, vo + (ai * HALF + m * 16) * 4, so, 0), b = (ssq_t)__builtin_amdgcn_raw_buffer_load_b32(rb, vo + (ai * HALF + m * 16) * 4, so, 0);
                rat[ai][m] = ss_rs(a) / ss_rs(b); }
    }
    __device__ __forceinline__ void operator()(const f32x4 (&acc)[2][2][4][2], const Unit& u, int wr, int wc, int fr, int fq) const {
        const int row0 = u.pm * BM + wr * 64 + fr, col0 = u.pn * BM + wc * 32 + 8 * fq;
        const __amdgpu_buffer_rsrc_t rb = __builtin_amdgcn_make_buffer_rsrc(const_cast<ssq_t*>(sss), 0, T_ * 4, 0x00020000);
        const int vo = (wr * 64 + fr) * 4, so = u.pm * BM * 4;
        ssq_t b[2][4];
#pragma unroll
        for (int ai = 0; ai < 2; ++ai)
#pragma unroll
            for (int m = 0; m < 4; ++m) b[ai][m] = (ssq_t)__builtin_amdgcn_raw_buffer_load_b32(rb, vo + (ai * HALF + m * 16) * 4, so, 0);
        __builtin_amdgcn_sched_barrier(0);
#pragma unroll
        for (int ai = 0; ai < 2; ++ai)
#pragma unroll
            for (int m = 0; m < 4; ++m) { const int row = row0 + ai * HALF + m * 16; bf16* rowp = O + (size_t)row * ldc + col0; const float sc = ss_rs(b[ai][m]);
#pragma unroll
                for (int bj = 0; bj < 2; ++bj) { const f32x4 v0 = acc[ai][bj][m][0] * sc, v1 = acc[ai][bj][m][1] * sc;
                    u32x4 w; w.x = cvt_pk_bf16(v0[0], v0[1]); w.y = cvt_pk_bf16(v0[2], v0[3]); w.z = cvt_pk_bf16(v1[0], v1[1]); w.w = cvt_pk_bf16(v1[2], v1[3]);
                    *(u32x4*)(rowp + bj * HALF) = w; } }
    }
};
struct EpiSwiGLU {
    static constexpr bool PERM = true; static constexpr bool KSPLIT = false;
    bf16* O; int ldc; const float* rs;
    __device__ __forceinline__ void operator()(const f32x4 (&acc)[2][2][4][2], const Unit& u, int wr, int wc, int fr, int fq) const {
        const int row0 = u.pm * BM + wr * 64 + fr, col0 = u.pn * HALF + wc * 32 + 8 * fq;
        float scv[2][4];
#pragma unroll
        for (int ai = 0; ai < 2; ++ai)
#pragma unroll
            for (int m = 0; m < 4; ++m) scv[ai][m] = rs[row0 + ai * HALF + m * 16];
        __builtin_amdgcn_sched_barrier(0);
#pragma unroll
        for (int ai = 0; ai < 2; ++ai)
#pragma unroll
            for (int m = 0; m < 4; ++m) { const int row = row0 + ai * HALF + m * 16; bf16* rowp = O + (size_t)row * ldc + col0; const float sc = scv[ai][m];
                float h[8];
#pragma unroll
                for (int n = 0; n < 2; ++n)
#pragma unroll
                    for (int j = 0; j < 4; ++j) { const float g = acc[ai][0][m][n][j] * sc, up = acc[ai][1][m][n][j] * sc; h[n * 4 + j] = g * fast_sigmoid(g) * up; }
                u32x4 w; w.x = cvt_pk_bf16(h[0], h[1]); w.y = cvt_pk_bf16(h[2], h[3]); w.z = cvt_pk_bf16(h[4], h[5]); w.w = cvt_pk_bf16(h[6], h[7]);
                *(u32x4*)rowp = w; }
    }
};
template <bool DIRECT> struct EpiSwiGLU8 {
    static constexpr bool PERM = true; static constexpr bool KSPLIT = false;
    unsigned char* O; int ldc; const float* rs; float mul = 1.0f;
    __device__ __forceinline__ void operator()(const f32x4 (&acc)[2][2][4][2], const Unit& u, int wr, int wc, int fr, int fq) const {
        const int r0 = wr * 64 + fr, row0 = u.pm * BM + r0, col0 = u.pn * HALF + wc * 32 + 8 * fq;
        int tkv[2][4]; float scv[2][4];
#pragma unroll
        for (int ai = 0; ai < 2; ++ai)
#pragma unroll
            for (int m = 0; m < 4; ++m) { const int rl = r0 + ai * HALF + m * 16; if constexpr (DIRECT) tkv[ai][m] = row0 + ai * HALF + m * 16; else tkv[ai][m] = u.lst[rl < u.nvalid ? rl : 0].x; }
        __builtin_amdgcn_sched_barrier(0);
#pragma unroll
        for (int ai = 0; ai < 2; ++ai)
#pragma unroll
            for (int m = 0; m < 4; ++m) scv[ai][m] = rs[tkv[ai][m]];
        __builtin_amdgcn_sched_barrier(0);
#pragma unroll
        for (int ai = 0; ai < 2; ++ai)
#pragma unroll
            for (int m = 0; m < 4; ++m) { const int rl = r0 + ai * HALF + m * 16; unsigned char* rowp = O + (size_t)(row0 + ai * HALF + m * 16) * ldc + col0;
                const float sc = (DIRECT || rl < u.nvalid) ? scv[ai][m] * mul : 0.f;
                float h[8];
#pragma unroll
                for (int n = 0; n < 2; ++n)
#pragma unroll
                    for (int j = 0; j < 4; ++j) { const float g = acc[ai][0][m][n][j] * sc, up = acc[ai][1][m][n][j] * sc; h[n * 4 + j] = g * fast_sigmoid(g) * up; }
                const u32x2 w = {cvt4_fp8(h[0], h[1], h[2], h[3]), cvt4_fp8(h[4], h[5], h[6], h[7])};
                *(u32x2*)rowp = w; }
    }
};
struct EpiGLU {
    static constexpr bool PERM = true; static constexpr bool KSPLIT = false;
    bf16* O; const bf16* Y; int ldc; const float* bias; ssq_t* ss;
    __device__ __forceinline__ void operator()(const f32x4 (&acc)[2][2][4][2], const Unit& u, int wr, int wc, int fr, int fq) const {
        const int row0 = u.pm * BM + wr * 64 + fr, col0 = u.pn * BM + wc * 32 + 8 * fq;
        f32x4 bv[2][2];
#pragma unroll
        for (int bj = 0; bj < 2; ++bj)
#pragma unroll
            for (int n = 0; n < 2; ++n) bv[bj][n] = *(const f32x4*)(bias + col0 + bj * HALF + 4 * n);
#pragma unroll
        for (int ai = 0; ai < 2; ++ai) {
        u32x4 yvv[4][2];
#pragma unroll
            for (int m = 0; m < 4; ++m)
#pragma unroll
                for (int bj = 0; bj < 2; ++bj) yvv[m][bj] = *(const u32x4*)(Y + (size_t)(row0 + ai * HALF + m * 16) * ldc + col0 + bj * HALF);
        __builtin_amdgcn_sched_barrier(0);
#pragma unroll
            for (int m = 0; m < 4; ++m) { const size_t off = (size_t)(row0 + ai * HALF + m * 16) * ldc + col0; float sq = 0.f;
#pragma unroll
                for (int bj = 0; bj < 2; ++bj) { const u32x4 yv = yvv[m][bj];
                    const f32x4 v0 = acc[ai][bj][m][0] + bv[bj][0], v1 = acc[ai][bj][m][1] + bv[bj][1];
                    u32x4 w;
                    w.x = cvt_pk_bf16(bf_lo(yv.x) * fast_sigmoid(v0[0]), bf_hi(yv.x) * fast_sigmoid(v0[1]));
                    w.y = cvt_pk_bf16(bf_lo(yv.y) * fast_sigmoid(v0[2]), bf_hi(yv.y) * fast_sigmoid(v0[3]));
                    w.z = cvt_pk_bf16(bf_lo(yv.z) * fast_sigmoid(v1[0]), bf_hi(yv.z) * fast_sigmoid(v1[1]));
                    w.w = cvt_pk_bf16(bf_lo(yv.w) * fast_sigmoid(v1[2]), bf_hi(yv.w) * fast_sigmoid(v1[3]));
                    *(u32x4*)(O + off + bj * HALF) = w;
                    if (MERGE_FUSED) { sq += bf_lo(w.x) * bf_lo(w.x) + bf_hi(w.x) * bf_hi(w.x) + bf_lo(w.y) * bf_lo(w.y) + bf_hi(w.y) * bf_hi(w.y) + bf_lo(w.z) * bf_lo(w.z) + bf_hi(w.z) * bf_hi(w.z) + bf_lo(w.w) * bf_lo(w.w) + bf_hi(w.w) * bf_hi(w.w); } }
                if (MERGE_FUSED && ss != nullptr) { sq += __shfl_xor(sq, 16); sq += __shfl_xor(sq, 32);
                    if (fq == 0) __hip_atomic_fetch_add(ss + row0 + ai * HALF + m * 16, ss_fix(sq), RLX_AGENT); } }
        __builtin_amdgcn_sched_barrier(0);
        }
    }
};
struct EpiMoeDown {
    static constexpr bool PERM = true; static constexpr bool KSPLIT = false;
    bf16* O; int ldc;
    __device__ __forceinline__ void operator()(const f32x4 (&acc)[2][2][4][2], const Unit& u, int wr, int wc, int fr, int fq) const {
        const int r0 = wr * 64 + fr, row0 = u.pm * BM + r0, col0 = u.pn * BM + wc * 32 + 8 * fq;
        float gtv[2][4];
#pragma unroll
        for (int ai = 0; ai < 2; ++ai)
#pragma unroll
            for (int m = 0; m < 4; ++m) { const int rl = r0 + ai * HALF + m * 16; const float gl = __int_as_float(u.lst[rl < u.nvalid ? rl : 0].y); gtv[ai][m] = (rl < u.nvalid) ? gl : 0.f; }
        __builtin_amdgcn_sched_barrier(0);
#pragma unroll
        for (int ai = 0; ai < 2; ++ai)
#pragma unroll
            for (int m = 0; m < 4; ++m) { const int rl = r0 + ai * HALF + m * 16;
                const float gt = gtv[ai][m];
                bf16* rowp = O + (size_t)(row0 + ai * HALF + m * 16) * ldc + col0;
#pragma unroll
                for (int bj = 0; bj < 2; ++bj) { const f32x4 v0 = acc[ai][bj][m][0] * gt, v1 = acc[ai][bj][m][1] * gt;
                    if (MOE_Y8) { const u32x2 w8 = {cvt4_fp8(v0[0] * 16.f, v0[1] * 16.f, v0[2] * 16.f, v0[3] * 16.f), cvt4_fp8(v1[0] * 16.f, v1[1] * 16.f, v1[2] * 16.f, v1[3] * 16.f)};
                        *(u32x2*)((unsigned char*)O + (size_t)(row0 + ai * HALF + m * 16) * ldc + col0 + bj * HALF) = w8; }
                    else { u32x4 w; w.x = cvt_pk_bf16(v0[0], v0[1]); w.y = cvt_pk_bf16(v0[2], v0[3]); w.z = cvt_pk_bf16(v1[0], v1[1]); w.w = cvt_pk_bf16(v1[2], v1[3]);
                    *(u32x4*)(rowp + bj * HALF) = w; } } }
    }
};

typedef int i32x8 __attribute__((ext_vector_type(8)));
typedef short s16x16 __attribute__((ext_vector_type(16)));
template <class Epi, class Sched, bool GATHER, bool F8 = false>
__device__ __forceinline__ void gemm_phase(LAS unsigned char* lds, const int rowb, const Sched& S, const Epi& E, const int wave_id) {
    int lane_ = lane_now();
    const int wid = wave_id, lane = lane_, tid = wid * 64 + lane, wr = wid >> 2, wc = wid & 3, fr = lane & 15, fq = lane >> 4;
    const int nt = rowb / 128, nth = nt >> 1;
    const int rowbA = Epi::KSPLIT ? rowb / 2 : rowb;
    unsigned voffA[2], voffB[2];
#pragma unroll
    for (int i = 0; i < 2; ++i) { int R, C; if constexpr (F8) stage_rc8(tid * 16 + i * 8192, R, C); else stage_rc(tid * 16 + i * 8192, R, C); const int Rb = Epi::PERM ? ((R & ~31) + perm32(R & 31)) : R;
        voffA[i] = (unsigned)(R * rowbA + C * 2); voffB[i] = (unsigned)(Rb * rowb + C * 2); }
    const size_t kstep = (size_t)(BK * 2);
    const size_t hstep = (size_t)HALF * rowb, hstepA = (size_t)HALF * rowbA;
    const unsigned ldsw = (unsigned)wid * 1024u;
    const int aoff = F8 ? lds_byte8(wr * 64 + fr, fq * 16) : lds_byte(wr * 64 + fr, fq * 8), boff = F8 ? lds_byte8(wc * 32 + fr, fq * 16) : lds_byte(wc * 32 + fr, fq * 8);
    const int aoff1 = aoff ^ 16, boff1 = boff ^ 16;
#define PG8_SA(b, h) (((b) * 2 + (h)) * HTB)
#define PG8_SB(b, h) ((4 + (b) * 2 + (h)) * HTB)
#define PG8_GL(bufoff, gptr, i) __builtin_amdgcn_global_load_lds((const unsigned*)(gptr), (LAS unsigned*)(lds + (bufoff) + ldsw + (i) * 8192), 16, 0, 0)
#define PG8_STAGE_B(bufoff, gbase) do { PG8_GL(bufoff, (const char*)(gbase) + voffB[0], 0); PG8_GL(bufoff, (const char*)(gbase) + voffB[1], 1); } while (0)
#define PG8_STAGE_A(bufoff, kp, h, g0, g1) do { if constexpr (GATHER) { PG8_GL(bufoff, (const char*)(kp) + (g0), 0); PG8_GL(bufoff, (const char*)(kp) + (g1), 1); } \
        else { PG8_GL(bufoff, (const char*)(kp) + (h) * hstepA + voffA[0], 0); PG8_GL(bufoff, (const char*)(kp) + (h) * hstepA + voffA[1], 1); } } while (0)
#define PG8_CAT(x, y) __builtin_shufflevector(__builtin_bit_cast(i32x4, x), __builtin_bit_cast(i32x4, y), 0, 1, 2, 3, 4, 5, 6, 7)
#define PG8_LDA(dst, b, h) do { _Pragma("unroll") for (int m = 0; m < 4; ++m) { if constexpr (F8) dst##8[m] = PG8_CAT(*(const LAS bf16x8*)(lds + PG8_SA(b, h) + aoff + m * 2048), *(const LAS bf16x8*)(lds + PG8_SA(b, h) + aoff1 + m * 2048)); \
        else { _Pragma("unroll") for (int k = 0; k < 2; ++k) dst[m][k] = *(const LAS bf16x8*)(lds + PG8_SA(b, h) + aoff + m * 2048 + k * 1024); } } } while (0)
#define PG8_LDB(dst, b, h) do { _Pragma("unroll") for (int n = 0; n < 2; ++n) { if constexpr (F8) dst##8[n] = PG8_CAT(*(const LAS bf16x8*)(lds + PG8_SB(b, h) + boff + n * 2048), *(const LAS bf16x8*)(lds + PG8_SB(b, h) + boff1 + n * 2048)); \
        else { _Pragma("unroll") for (int k = 0; k < 2; ++k) dst[n][k] = *(const LAS bf16x8*)(lds + PG8_SB(b, h) + boff + n * 2048 + k * 1024); } } } while (0)
#define PG8_MMA(ai, bj, At, Bt) do { __builtin_amdgcn_s_setprio(1); _Pragma("unroll") for (int m = 0; m < 4; ++m) _Pragma("unroll") for (int n = 0; n < 2; ++n) { \
        if constexpr (F8) asm volatile("v_mfma_scale_f32_16x16x128_f8f6f4 %0, %1, %2, %0, %3, %4 op_sel_hi:[0,0,0]" : "+v"(acc[ai][bj][m][n]) : "v"(Bt##8[n]), "v"(At##8[m]), "v"(sclW), "v"(sclX)); \
        else { _Pragma("unroll") for (int k = 0; k < 2; ++k) acc[ai][bj][m][n] = __builtin_amdgcn_mfma_f32_16x16x32_bf16(Bt[n][k], At[m][k], acc[ai][bj][m][n], 0, 0, 0); } } \
        __builtin_amdgcn_s_setprio(0); } while (0)
#define PG8_WAIT_V(n) asm volatile("s_waitcnt vmcnt(" #n ")" ::: "memory")
#define PG8_WAIT_L(n) asm volatile("s_waitcnt lgkmcnt(" #n ")" ::: "memory")
#define PG8_BAR __builtin_amdgcn_s_barrier()
#define PG8_SCHED __builtin_amdgcn_sched_barrier(0)
#define PG8_GOFF(dst, u) do { _Pragma("unroll") for (int i = 0; i < 2; ++i) { int R_, C_; if constexpr (F8) stage_rc8(tid * 16 + i * 8192, R_, C_); else stage_rc(tid * 16 + i * 8192, R_, C_); _Pragma("unroll") for (int h = 0; h < 2; ++h) { const int r_ = h * HALF + R_; \
        const int tok_ = (u).lst[r_ < (u).nvalid ? r_ : 0].x; dst[h][i] = (unsigned)tok_ * (unsigned)rowb + (unsigned)(C_ * 2); } } } while (0)
    Unit cur, nxt; int ui = 0;
    if (!S.next(0, cur)) return;
    f32x4 acc[2][2][4][2];
#pragma unroll
    for (int a = 0; a < 2; ++a)
#pragma unroll
        for (int b = 0; b < 2; ++b)
#pragma unroll
            for (int m = 0; m < 4; ++m)
#pragma unroll
                for (int n = 0; n < 2; ++n) acc[a][b][m][n] = (f32x4){0.f, 0.f, 0.f, 0.f};
    bf16x8 At[4][2], B0[2][2], B1[2][2]; i32x8 At8[4], B08[2], B18[2];
    int sclW = 0x79797979, sclX = 0x7F7F7F7F; if constexpr (F8) { asm volatile("" : "+v"(sclW), "+v"(sclX)); }
    unsigned gc[2][2] = {{0u, 0u}, {0u, 0u}}, gn[2][2] = {{0u, 0u}, {0u, 0u}};
    if constexpr (GATHER) { PG8_GOFF(gc, cur); }
    const char* cA = cur.A; const char* cB = cur.B;
    PG8_STAGE_B(PG8_SB(0, 0), cB); PG8_STAGE_B(PG8_SB(0, 1), cB + hstep); PG8_STAGE_A(PG8_SA(0, 0), cA, 0, gc[0][0], gc[0][1]); PG8_STAGE_A(PG8_SA(0, 1), cA, 1, gc[1][0], gc[1][1]);
    if (wr == 1) PG8_BAR;
    PG8_WAIT_V(2); PG8_BAR;
    PG8_STAGE_B(PG8_SB(1, 0), cB + kstep); PG8_STAGE_A(PG8_SA(1, 0), cA + kstep, 0, gc[0][0], gc[0][1]); PG8_STAGE_B(PG8_SB(1, 1), cB + hstep + kstep);
    PG8_WAIT_V(6); PG8_BAR;
    for (;;) {
        const bool has_next = S.next(ui + 1, nxt);
        const char* nA = has_next ? nxt.A : cA; const char* nB = has_next ? nxt.B : cB;
        const char* cA2 = cA;
        if constexpr (Epi::KSPLIT) cA2 = cur.A2 - (size_t)nth * kstep;
        if constexpr (GATHER) { if (has_next) { PG8_GOFF(gn, nxt); } else {
#pragma unroll
            for (int h = 0; h < 2; ++h)
#pragma unroll
                for (int i = 0; i < 2; ++i) gn[h][i] = gc[h][i]; } }
        for (int t = 0; t < nt; t += 2) {
            const bool last = (t == nt - 2);
            const char* pa = (Epi::KSPLIT && t >= nth) ? cA2 : cA; const char* pa2 = (Epi::KSPLIT && t + 2 >= nth) ? cA2 : cA;
            if constexpr (Epi::KSPLIT) { if (t == nth) {
                float rat[2][4]; E.ratios(rat, cur, wr, fr);
#pragma unroll
                for (int a = 0; a < 2; ++a)
#pragma unroll
                    for (int b = 0; b < 2; ++b)
#pragma unroll
                        for (int m = 0; m < 4; ++m)
#pragma unroll
                            for (int n = 0; n < 2; ++n) acc[a][b][m][n] *= rat[a][m]; } }
            const char* a1 = pa + (size_t)(t + 1) * kstep;
            const char* a2 = last ? nA : pa2 + (size_t)(t + 2) * kstep; const char* b2 = last ? nB : cB + (size_t)(t + 2) * kstep;
            const char* a3 = a2 + kstep; const char* b3 = b2 + kstep;
            const unsigned g00 = last ? gn[0][0] : gc[0][0], g01 = last ? gn[0][1] : gc[0][1], g10 = last ? gn[1][0] : gc[1][0], g11 = last ? gn[1][1] : gc[1][1];
            PG8_LDB(B0, 0, 0); PG8_LDB(B1, 0, 1); PG8_SCHED; PG8_LDA(At, 0, 0); PG8_STAGE_A(PG8_SA(1, 1), a1, 1, gc[1][0], gc[1][1]);
            PG8_WAIT_V(8); PG8_WAIT_L(0); PG8_BAR; PG8_MMA(0, 0, At, B0); PG8_MMA(0, 1, At, B1); PG8_BAR; PG8_SCHED;
            PG8_LDA(At, 0, 1); PG8_STAGE_B(PG8_SB(0, 0), b2); PG8_STAGE_B(PG8_SB(0, 1), b2 + hstep); PG8_STAGE_A(PG8_SA(0, 0), a2, 0, g00, g01);
            PG8_WAIT_V(8); PG8_WAIT_L(0); PG8_BAR; PG8_MMA(1, 0, At, B0); PG8_MMA(1, 1, At, B1); PG8_BAR; PG8_SCHED;
            PG8_LDB(B0, 1, 0); PG8_LDB(B1, 1, 1); PG8_SCHED; PG8_LDA(At, 1, 0); PG8_STAGE_A(PG8_SA(0, 1), a2, 1, g10, g11);
            PG8_WAIT_V(8); PG8_WAIT_L(0); PG8_BAR; PG8_MMA(0, 0, At, B0); PG8_MMA(0, 1, At, B1); PG8_BAR; PG8_SCHED;
            PG8_LDA(At, 1, 1); PG8_STAGE_B(PG8_SB(1, 0), b3); PG8_STAGE_B(PG8_SB(1, 1), b3 + hstep); PG8_STAGE_A(PG8_SA(1, 0), a3, 0, g00, g01);
            PG8_WAIT_V(8); PG8_WAIT_L(0); PG8_BAR; PG8_MMA(1, 0, At, B0); PG8_MMA(1, 1, At, B1); PG8_BAR; PG8_SCHED;
        }
        if (wr == 0) PG8_BAR;
        if constexpr (F8) { asm volatile("s_nop 15\n\ts_nop 15\n\ts_nop 7" ::: "memory"); }
        E(acc, cur, wr, wc, fr, fq);
        if (!has_next) break;
#pragma unroll
        for (int a = 0; a < 2; ++a)
#pragma unroll
            for (int b = 0; b < 2; ++b)
#pragma unroll
                for (int m = 0; m < 4; ++m)
#pragma unroll
                    for (int n = 0; n < 2; ++n) acc[a][b][m][n] = (f32x4){0.f, 0.f, 0.f, 0.f};
        cur = nxt; cA = nA; cB = nB; ++ui;
        if constexpr (GATHER) {
#pragma unroll
            for (int h = 0; h < 2; ++h)
#pragma unroll
                for (int i = 0; i < 2; ++i) gc[h][i] = gn[h][i]; }
        if (wr == 1) PG8_BAR;
    }
    PG8_WAIT_V(0);
    PG8_BAR;
#undef PG8_SA
#undef PG8_SB
#undef PG8_GL
#undef PG8_STAGE_B
#undef PG8_STAGE_A
#undef PG8_LDA
#undef PG8_LDB
#undef PG8_MMA
#undef PG8_CAT
#undef PG8_WAIT_V
#undef PG8_WAIT_L
#undef PG8_BAR
#undef PG8_SCHED
#undef PG8_GOFF
}
}

namespace sba {
constexpr int SHM_T = 64 * 128 * 2;
constexpr float EXIT_THR = 160.f;
#define SBA_KSWZ(row, colB) ((row) * 256 + ((colB) ^ (((row) & 7) << 4)))
#define SBA_SBAR() __builtin_amdgcn_sched_barrier(0)
__device__ __forceinline__ int crow(int r, int hi) { return (r & 3) + 8 * (r >> 2) + 4 * hi; }
__device__ __forceinline__ void qkt(f32x16& p0, f32x16& p1, const LAS char* Ks, const bf16x8* qr, int r32, int hi) {
    p0 = f32x16{}; p1 = f32x16{};
#pragma unroll
    for (int d0 = 0; d0 < 8; ++d0) { const int cb = (d0 * 16 + hi * 8) * 2;
        const bf16x8 b0 = *(const LAS bf16x8*)(Ks + SBA_KSWZ(r32, cb));
        const bf16x8 b1 = *(const LAS bf16x8*)(Ks + SBA_KSWZ(32 + r32, cb));
        p0 = __builtin_amdgcn_mfma_f32_32x32x16_bf16(b0, qr[d0], p0, 0, 0, 0);
        p1 = __builtin_amdgcn_mfma_f32_32x32x16_bf16(b1, qr[d0], p1, 0, 0, 0); }
}
__device__ __forceinline__ int v_st(int k, int c) { const int kk = (k & ~0xC) | ((k & 4) << 1) | ((k & 8) >> 1); return ((kk >> 3) * 4 + (c >> 5)) * 512 + ((kk & 7) * 32 + (c & 31)) * 2; }
__device__ __forceinline__ int v_rd_base(int lane) { return ((lane & 3) << 3) | (((lane >> 2) & 3) << 6) | (((lane >> 4) & 1) << 5) | (((lane >> 5) & 1) << 8); }
constexpr int v_rd_off(int d0, int ks, int half) { return d0 * 512 + ks * 4096 + half * 2048; }
template <int OFF> __device__ __forceinline__ s16x4 tr_read(int vb) {
    s16x4 r; asm volatile("ds_read_b64_tr_b16 %0, %1 offset:%2" : "=&v"(r) : "v"(vb), "i"(OFF) : "memory"); return r;
}
template <int D0> __device__ __forceinline__ void pv_one(f32x16& od, int vb, bf16x8 pa0, bf16x8 pa1, bf16x8 pa2, bf16x8 pa3) {
    const s16x4 l0 = tr_read<v_rd_off(D0, 0, 0)>(vb), h0 = tr_read<v_rd_off(D0, 0, 1)>(vb), l1 = tr_read<v_rd_off(D0, 1, 0)>(vb), h1 = tr_read<v_rd_off(D0, 1, 1)>(vb);
    const s16x4 l2 = tr_read<v_rd_off(D0, 2, 0)>(vb), h2 = tr_read<v_rd_off(D0, 2, 1)>(vb), l3 = tr_read<v_rd_off(D0, 3, 0)>(vb), h3 = tr_read<v_rd_off(D0, 3, 1)>(vb);
    asm volatile("s_waitcnt lgkmcnt(0)" ::: "memory"); SBA_SBAR();
#define SBA_PK(L, H) (bf16x8){L[0], L[1], L[2], L[3], H[0], H[1], H[2], H[3]}
    od = __builtin_amdgcn_mfma_f32_32x32x16_bf16(pa0, SBA_PK(l0, h0), od, 0, 0, 0);
    od = __builtin_amdgcn_mfma_f32_32x32x16_bf16(pa1, SBA_PK(l1, h1), od, 0, 0, 0);
    od = __builtin_amdgcn_mfma_f32_32x32x16_bf16(pa2, SBA_PK(l2, h2), od, 0, 0, 0);
    od = __builtin_amdgcn_mfma_f32_32x32x16_bf16(pa3, SBA_PK(l3, h3), od, 0, 0, 0);
#undef SBA_PK
}
__device__ __forceinline__ float partner32(float x, const int hi) {
    const auto rr = __builtin_amdgcn_permlane32_swap(__float_as_uint(x), __float_as_uint(x), false, false);
    return hi ? __uint_as_float(rr[0]) : __uint_as_float(rr[1]);
}
__device__ __forceinline__ float sp2(float x) { const float r = __builtin_amdgcn_logf(1.0f + __builtin_amdgcn_exp2f(x)); return x > 30.f ? x : r; }

__device__ __forceinline__ void sb_unit(const bf16* __restrict__ proj, bf16* __restrict__ out, const int t0, const int h, const float kabs, LAS char* lds, const int wave_id, ssq_t* ssrow) {
    int lane_ = lane_now();
    const int wid = wave_id, lane = lane_, tid = wid * 64 + lane, r32 = lane & 31, hi = lane >> 5;
    LAS char* Kl = lds; LAS char* Vl = lds + 2 * SHM_T; volatile LAS int* flags = (volatile LAS int*)(lds + 4 * SHM_T);
    const int rw0 = t0 + 32 * wid, trow = rw0 + r32;
    const bf16* qp = proj + (size_t)trow * DIN + h * 128 + hi * 8;
    bf16x8 qr[8]; float qa = 0.f;
#pragma unroll
    for (int d0 = 0; d0 < 8; ++d0) { const u32x4 w = *(const u32x4*)(qp + d0 * 16); qr[d0] = __builtin_bit_cast(bf16x8, w);
        qa += fabsf(bf_lo(w.x)) + fabsf(bf_hi(w.x)) + fabsf(bf_lo(w.y)) + fabsf(bf_hi(w.y)) + fabsf(bf_lo(w.z)) + fabsf(bf_hi(w.z)) + fabsf(bf_lo(w.w)) + fabsf(bf_hi(w.w)); }
    qa += partner32(qa, hi);
    const float sthr = EXIT_THR + 1.01f * qa * kabs;
    const int sr = tid >> 4, sc = (tid & 15) * 8, vst0 = v_st(sr, sc), vst1 = v_st(32 + sr, sc), kst0 = SBA_KSWZ(sr, sc * 2), kst1 = SBA_KSWZ(32 + sr, sc * 2);
    const bf16* kg = proj + DSB + h * 128 + sc; const bf16* vg = proj + 2 * DSB + h * 128 + sc;
    const int vb0 = (int)(uintptr_t)Vl + v_rd_base(lane);
    f32x16 o[4] = {};
    float S = 0.f; bool wdone = false;
    u32x4 sk0, sk1, sv0, sv1;
#define SBA_SLOAD(kb) do { sk0 = *(const u32x4*)(kg + (size_t)((kb) + sr) * DIN); sk1 = *(const u32x4*)(kg + (size_t)((kb) + 32 + sr) * DIN); \
        sv0 = *(const u32x4*)(vg + (size_t)((kb) + sr) * DIN); sv1 = *(const u32x4*)(vg + (size_t)((kb) + 32 + sr) * DIN); } while (0)
#define SBA_SWRITE(b) do { *(LAS u32x4*)(Kl + (b) * SHM_T + kst0) = sk0; *(LAS u32x4*)(Kl + (b) * SHM_T + kst1) = sk1; \
        *(LAS u32x4*)(Vl + (b) * SHM_T + vst0) = sv0; *(LAS u32x4*)(Vl + (b) * SHM_T + vst1) = sv1; } while (0)
    const int jhi = (t0 >> 6) + 3;
    __syncthreads();
    SBA_SLOAD(jhi * 64); SBA_SWRITE(0); __syncthreads();
    int cur = 0;
    for (int j = jhi; j >= 0; --j) {
        const int kb = j * 64;
        if (j > 0) SBA_SLOAD(kb - 64);
        const bool active = !wdone && (kb < rw0 + 31);
        if (active) {
            f32x16 p0, p1;
            qkt(p0, p1, Kl + cur * SHM_T, qr, r32, hi);
            if (kb + 63 >= rw0) {
#pragma unroll
                for (int r = 0; r < 16; ++r) { const int key = kb + crow(r, hi); if (key >= trow) p0[r] = -1e30f; if (key + 32 >= trow) p1[r] = -1e30f; }
            }
            float x[32];
#pragma unroll
            for (int r = 0; r < 16; ++r) { x[r] = sp2(p0[r]); x[16 + r] = sp2(p1[r]); }
            float gs[8], og[8], a[8], R[8];
#pragma unroll
            for (int i = 0; i < 8; ++i) { x[4 * i + 2] += x[4 * i + 3]; x[4 * i + 1] += x[4 * i + 2]; x[4 * i] += x[4 * i + 1]; gs[i] = x[4 * i]; }
#pragma unroll
            for (int i = 0; i < 8; ++i) { og[i] = partner32(gs[i], hi); a[i] = gs[i] + og[i]; }
            R[7] = 0.f;
#pragma unroll
            for (int i = 6; i >= 0; --i) R[i] = R[i + 1] + a[i + 1];
            const float tot = R[0] + a[0];
#pragma unroll
            for (int i = 0; i < 8; ++i) { const float e = S + R[i] + (hi == 0 ? og[i] : 0.f);
#pragma unroll
                for (int q = 0; q < 4; ++q) { const int r = 4 * i + q; const float z = (r < 16) ? p0[r & 15] : p1[r & 15]; x[r] = __builtin_amdgcn_exp2f(z - x[r] - e); } }
            S += tot;
            bf16x8 pa0, pa1, pa2, pa3;
#define SBA_PK4(B0_, OUT) do { const unsigned a0 = cvt_pk_bf16(x[B0_ + 0], x[B0_ + 1]), a1 = cvt_pk_bf16(x[B0_ + 2], x[B0_ + 3]); \
        const unsigned b0 = cvt_pk_bf16(x[B0_ + 4], x[B0_ + 5]), b1 = cvt_pk_bf16(x[B0_ + 6], x[B0_ + 7]); \
        const auto r0 = __builtin_amdgcn_permlane32_swap(a0, b0, false, false); const auto r1 = __builtin_amdgcn_permlane32_swap(a1, b1, false, false); \
        const u32x4 w = {r0[0], r1[0], r0[1], r1[1]}; OUT = __builtin_bit_cast(bf16x8, w); } while (0)
            SBA_PK4(0, pa0); SBA_PK4(8, pa1); SBA_PK4(16, pa2); SBA_PK4(24, pa3);
#undef SBA_PK4
            const int vb = vb0 + cur * SHM_T;
            pv_one<0>(o[0], vb, pa0, pa1, pa2, pa3); pv_one<1>(o[1], vb, pa0, pa1, pa2, pa3); pv_one<2>(o[2], vb, pa0, pa1, pa2, pa3); pv_one<3>(o[3], vb, pa0, pa1, pa2, pa3);
            wdone = __all(S >= sthr);
        }
        if (lane == 0) flags[wid] = (wdone || j == 0) ? 1 : 0;
        __syncthreads();
        int alld = 1;
#pragma unroll
        for (int w = 0; w < NWAVES; ++w) alld &= flags[w];
        if (alld) break;
        SBA_SWRITE(cur ^ 1);
        __syncthreads();
        cur ^= 1;
    }
    bf16* op = out + (size_t)rw0 * DSB + h * 128 + r32;
#pragma unroll
    for (int r = 0; r < 16; ++r) { const int orow = crow(r, hi); float sq = 0.f;
#pragma unroll
        for (int d0 = 0; d0 < 4; ++d0) { const unsigned w = cvt_pk_bf16(o[d0][r], 0.f); op[(size_t)orow * DSB + d0 * 32] = (bf16)(w & 0xffffu); const float v = bf_lo(w); sq += v * v; }
        if (MERGE_FUSED) {
            sq += __shfl_xor(sq, 1); sq += __shfl_xor(sq, 2); sq += __shfl_xor(sq, 4); sq += __shfl_xor(sq, 8); sq += __shfl_xor(sq, 16);
            if (r32 == 0) __hip_atomic_fetch_add(ssrow + rw0 + orow, ss_fix(sq), RLX_AGENT); } }
#undef SBA_SLOAD
#undef SBA_SWRITE
}
}

__device__ __forceinline__ void ssm_state_item(const bf16* __restrict__ proj, const bf16* __restrict__ Wm, float* __restrict__ sst, const int g, const int ct, int lane) {
    asm volatile("" : "+v"(lane));
    const int cl = lane & 31, hh = lane >> 5, c = ct * 32 + cl;
    const bf16* up = proj + (size_t)(c * LCH) * DIN + 3 * DSB + 16 * g + 8 * hh;
    bf16x8 ub[16];
#pragma unroll
    for (int j = 0; j < 16; ++j) ub[j] = *(const bf16x8*)(up + (size_t)j * DIN);
    f32x16 acc[4];
#pragma unroll
    for (int rt = 0; rt < 4; ++rt) {
        acc[rt] = f32x16{};
        const bf16* wp = Wm + ((size_t)((g * 4 + rt) * 16) * 64 + lane) * 8;
        bf16x8 af[16];
#pragma unroll
        for (int ks = 0; ks < 16; ++ks) af[ks] = *(const bf16x8*)(wp + ks * 512);
        __builtin_amdgcn_sched_barrier(0);
#pragma unroll
        for (int ks = 0; ks < 16; ++ks) acc[rt] = __builtin_amdgcn_mfma_f32_32x32x16_bf16(af[ks], ub[ks], acc[rt], 0, 0, 0);
        __builtin_amdgcn_sched_barrier(0);
    }
#pragma unroll
    for (int rt = 0; rt < 4; ++rt)
#pragma unroll
        for (int r = 0; r < 16; ++r) sst[(size_t)(g * 128 + rt * 32 + sba::crow(r, hh)) * NCH + c] = acc[rt][r];
}
constexpr int SCAN_ITEMS = 256;
__device__ __forceinline__ void ssm_scan_item(float* __restrict__ sst, const f32x2* __restrict__ aux, const int it, LAS char* lds, const int tid_in) {
    int tid_ = tid_in; asm volatile("" : "+v"(tid_));
    const int tid = tid_, pr = tid >> 5, seg = tid & 31, q = it * 16 + pr, g = q >> 6, p = q & 63;
    float* re = sst + (size_t)(g * 128 + p) * NCH + seg * 32; float* im = re + (size_t)64 * NCH;
    const f32x2 A = aux[q]; const float ar = A.x, ai = A.y;
    LAS f32x2* ends = (LAS f32x2*)lds;
    f32x4 vr[8], vi[8];
#pragma unroll
    for (int i = 0; i < 8; ++i) { vr[i] = *(const f32x4*)(re + 4 * i); vi[i] = *(const f32x4*)(im + 4 * i); }
    float sr_ = 0.f, si_ = 0.f;
#pragma unroll
    for (int i = 0; i < 8; ++i)
#pragma unroll
        for (int k = 0; k < 4; ++k) { const float nr = ar * sr_ - ai * si_ + vr[i][k], ni = ar * si_ + ai * sr_ + vi[i][k]; sr_ = nr; si_ = ni; vr[i][k] = nr; vi[i][k] = ni; }
    __syncthreads();
    ends[pr * 32 + seg] = (f32x2){sr_, si_};
    __syncthreads();
    float br = ar, bi = ai;
#pragma unroll
    for (int k = 0; k < 5; ++k) { const float t = br * br - bi * bi; bi = 2.f * br * bi; br = t; }
    float cr = 0.f, ci = 0.f;
    for (int s = 0; s < seg; ++s) { const f32x2 e = ends[pr * 32 + s]; const float nr = br * cr - bi * ci + e.x, ni = br * ci + bi * cr + e.y; cr = nr; ci = ni; }
    float pr_ = ar, pi_ = ai;
#pragma unroll
    for (int i = 0; i < 8; ++i)
#pragma unroll
        for (int k = 0; k < 4; ++k) { vr[i][k] += pr_ * cr - pi_ * ci; vi[i][k] += pr_ * ci + pi_ * cr; const float t = pr_ * ar - pi_ * ai; pi_ = pr_ * ai + pi_ * ar; pr_ = t; }
#pragma unroll
    for (int i = 0; i < 8; ++i) { *(f32x4*)(re + 4 * i) = vr[i]; *(f32x4*)(im + 4 * i) = vi[i]; }
}
__device__ __forceinline__ void ssm_out_item(const bf16* __restrict__ proj, const bf16* __restrict__ TM, const float* __restrict__ sst, bf16* __restrict__ Y, const int g, const int ct, int lane) {
    asm volatile("" : "+v"(lane));
    const int cl = lane & 31, hh = lane >> 5, c = ct * 32 + cl;
    const bf16* up = proj + (size_t)(c * LCH) * DIN + 3 * DSB + 16 * g + 8 * hh;
    bf16x8 ub[16], sb[8];
#pragma unroll
    for (int j = 0; j < 16; ++j) ub[j] = *(const bf16x8*)(up + (size_t)j * DIN);
    const float* sp = sst + (size_t)(g * 128 + 8 * hh) * NCH + (c > 0 ? c - 1 : 0);
#pragma unroll
    for (int ks = 0; ks < 8; ++ks) { float v[8];
#pragma unroll
        for (int j = 0; j < 8; ++j) { const float t = sp[(size_t)(ks * 16 + j) * NCH]; v[j] = (c > 0) ? t : 0.f; }
        const u32x4 w = {cvt_pk_bf16(v[0], v[1]), cvt_pk_bf16(v[2], v[3]), cvt_pk_bf16(v[4], v[5]), cvt_pk_bf16(v[6], v[7])}; sb[ks] = __builtin_bit_cast(bf16x8, w); }
#pragma unroll
    for (int half = 0; half < 4; ++half) {
        f32x16 acc[2];
#pragma unroll
        for (int r4 = 0; r4 < 2; ++r4) { const int rt = half * 2 + r4;
            acc[r4] = f32x16{};
            const bf16* tp = TM + ((size_t)((g * 8 + rt) * 24) * 64 + lane) * 8;
            bf16x8 af[24];
#pragma unroll
            for (int j = 0; j < 16; ++j) if (j <= 2 * rt + 1) af[j] = *(const bf16x8*)(tp + j * 512);
#pragma unroll
            for (int ks = 0; ks < 8; ++ks) af[16 + ks] = *(const bf16x8*)(tp + (16 + ks) * 512);
            __builtin_amdgcn_sched_barrier(0);
#pragma unroll
            for (int j = 0; j < 16; ++j) if (j <= 2 * rt + 1) acc[r4] = __builtin_amdgcn_mfma_f32_32x32x16_bf16(af[j], ub[j], acc[r4], 0, 0, 0);
#pragma unroll
            for (int ks = 0; ks < 8; ++ks) acc[r4] = __builtin_amdgcn_mfma_f32_32x32x16_bf16(af[16 + ks], sb[ks], acc[r4], 0, 0, 0);
            __builtin_amdgcn_sched_barrier(0);
        }
#pragma unroll
        for (int r4 = 0; r4 < 2; ++r4) { const int rt = half * 2 + r4;
#pragma unroll
            for (int rg = 0; rg < 4; ++rg) { float v[4];
#pragma unroll
                for (int q = 0; q < 4; ++q) { const float xx = acc[r4][4 * rg + q]; const float u2 = 1.5957691216f * (xx + 0.044715f * xx * xx * xx); v[q] = xx * fast_sigmoid(u2); }
                const int t = c * LCH + 2 * rt + (rg >> 1), ch = 16 * g + 4 * hh + 8 * (rg & 1);
                const u32x2 w = {cvt_pk_bf16(v[0], v[1]), cvt_pk_bf16(v[2], v[3])};
                *(u32x2*)(Y + (size_t)t * DSSM + ch) = w; } }
    }
}

#define XB_TMO      128
#define XB_XCNT(j)  (256  + 64 * (j))
#define XB_XSUB(j)  (1280 + 64 * (j))
#define XB_XGEN(j)  (2304 + 64 * (j))
#define XB_TOP      3328
#define XB_TOPGEN   3392
#define XCD_BAR_WORDS 3456
#define XB_SPIN_CAP (1u << 20)
__device__ __forceinline__ unsigned xb_ld(unsigned* p)              { return __hip_atomic_load(p, __ATOMIC_RELAXED, __HIP_MEMORY_SCOPE_AGENT); }
__device__ __forceinline__ unsigned xb_add(unsigned* p, unsigned v) { return __hip_atomic_fetch_add(p, v, __ATOMIC_RELAXED, __HIP_MEMORY_SCOPE_AGENT); }
__device__ __forceinline__ unsigned xb_xcc_id() { return (unsigned)__builtin_amdgcn_s_getreg((3 << 11) | 20) & 0xFu; }
#define XB_SPIN(cond, bar) do { unsigned _sp = 0; while (cond) { __builtin_amdgcn_s_sleep(1); \
    if ((++_sp & 255u) == 0u) { if (xb_ld(&(bar)[XB_TMO])) break; if (_sp > XB_SPIN_CAP) { atomicAdd(&(bar)[XB_TMO], 1u); break; } } } } while (0)
struct XcdBarrier { unsigned* bar; unsigned x; volatile LAS unsigned* st; int wave; };
__device__ __forceinline__ bool xb_thread0(int wave) { return wave == 0 && lane_now() == 0; }
__device__ __forceinline__ XcdBarrier xcd_barrier_post(unsigned* bar, volatile LAS unsigned* st, int wave) {
    XcdBarrier b; b.bar = bar; b.x = xb_xcc_id(); b.st = st; b.wave = wave;
    if (xb_thread0(wave)) (void)xb_add(&bar[XB_XCNT(b.x)], 1u);
    return b;
}
__device__ __forceinline__ void xcd_barrier_complete(unsigned* bar, unsigned x, unsigned& nloc, unsigned& nx) {
    const unsigned G = gridDim.x * gridDim.y * gridDim.z;
    unsigned sum, cnt, mine, sp = 0u;
    for (;;) {
        sum = 0u; cnt = 0u; mine = 0u;
#pragma unroll
        for (unsigned j = 0; j < 16; ++j) { const unsigned c = xb_ld(&bar[XB_XCNT(j)]); sum += c; cnt += (c > 0u) ? 1u : 0u; mine = (j == x) ? c : mine; }
        if (sum == G) break;
        __builtin_amdgcn_s_sleep(1);
        if ((++sp & 255u) == 0u) { if (xb_ld(&bar[XB_TMO])) break; if (sp > XB_SPIN_CAP) { atomicAdd(&bar[XB_TMO], 1u); break; } }
    }
    nloc = mine > 0u ? mine : 1u; nx = cnt > 0u ? cnt : 1u;
}
__device__ __forceinline__ void xcd_barrier(const XcdBarrier& b_) {
    XcdBarrier b = b_; b.x = (unsigned)__builtin_amdgcn_readfirstlane((int)xb_xcc_id());
    asm volatile("s_waitcnt vmcnt(0)" ::: "memory");
    __syncthreads();
    if (xb_thread0(b.wave)) {
        unsigned* bar = b.bar;
        __builtin_amdgcn_s_waitcnt(0);
        unsigned nloc = b.st[0], nx = b.st[1];
        if (nloc == 0u) { xcd_barrier_complete(bar, b.x, nloc, nx); b.st[0] = nloc; b.st[1] = nx; }
        const unsigned old = xb_add(&bar[XB_XSUB(b.x)], 1u);
        const unsigned gen = old / nloc;
        if (old + 1u == (gen + 1u) * nloc) {
            __builtin_amdgcn_fence(__ATOMIC_RELEASE, "agent");
            asm volatile("s_waitcnt vmcnt(0)" ::: "memory");
            const unsigned og = xb_add(&bar[XB_TOP], 1u);
            const unsigned tg = og / nx;
            if (og + 1u == (tg + 1u) * nx) xb_add(&bar[XB_TOPGEN], 1u);
            else XB_SPIN(xb_ld(&bar[XB_TOPGEN]) == tg, bar);
            __builtin_amdgcn_fence(__ATOMIC_ACQUIRE, "agent");
            xb_add(&bar[XB_XGEN(b.x)], 1u);
            asm volatile("s_waitcnt vmcnt(0)" ::: "memory");
        } else {
            XB_SPIN(xb_ld(&bar[XB_XGEN(b.x)]) == gen, bar);
            __builtin_amdgcn_fence(__ATOMIC_ACQUIRE, "agent");
            asm volatile("s_waitcnt vmcnt(0)" ::: "memory");
        }
    }
    __syncthreads();
}

struct Params { const float* in[26]; float* out; unsigned char* ws; int ph_lo, ph_hi; };
enum { I_X = 0, I_APRE, I_APOST, I_FPRE, I_FPOST, I_WIN, I_LRE, I_LIM, I_LSTEP, I_BRE, I_BIM, I_CRE, I_CIM, I_SD, I_WGLU, I_BGLU, I_AON, I_SON, I_WOUT, I_FG, I_FU, I_FD, I_RT, I_MG, I_MU, I_MD };
struct Frame {
    LAS unsigned char* lds; GAS unsigned* ctl_; GAS unsigned char* ws_; const float* const* in; GAS float* out_;
    int tid, lane, wave, G, gw, NGW;
    __device__ __forceinline__ unsigned char* WS() const { return (unsigned char*)ws_; }
    __device__ __forceinline__ unsigned* CTL() const { return (unsigned*)ctl_; }
    __device__ __forceinline__ float* OUT() const { return (float*)out_; }
};

constexpr int CVT_P = 68;
constexpr int WIN8_NF = (16 - WIN8_TILES) * 256;
template <int SW>
__device__ __forceinline__ void cvt_load_tile(const float* __restrict__ W, const int N, const int k0, const int n0, const float* __restrict__ kg, LAS float* scr, const int lane) {
    const float* src = W + (size_t)(k0 + (lane >> 4)) * N + n0 + (lane & 15) * 4;
    f32x4 v[16];
#pragma unroll
    for (int i = 0; i < 16; ++i) v[i] = *(const f32x4*)(src + (size_t)(4 * i) * N);
    if (kg) {
#pragma unroll
        for (int i = 0; i < 16; ++i) v[i] = v[i] * kg[k0 + 4 * i + (lane >> 4)]; }
#pragma unroll
    for (int i = 0; i < 16; ++i) *(LAS f32x4*)(scr + (4 * i + (lane >> 4)) * CVT_P + (((lane & 15) * 4) ^ (SW == 1 ? 8 * (i >> 2) : 4 * (i >> 1)))) = v[i];
    LDS_WAIT(); asm volatile("" ::: "memory");
}
__device__ __forceinline__ void cvt_item(const float* __restrict__ W, const int K, const int N, bf16* __restrict__ WT, const int mode, const float scale, const int nscale, const float* __restrict__ kg, LAS float* scr, const int item, const int lane) {
    const int nblk = N >> 6, kb = item / nblk, nb = item - kb * nblk, k0 = kb << 6, n0 = nb << 6;
    cvt_load_tile<2>(W, N, k0, n0, kg, scr, lane);
    const int c = lane & 7;
    const float sc = (n0 < nscale) ? scale : 1.0f;
    const int drow0 = (mode == 0) ? n0 : ((n0 >> 7) * 256 + (n0 & 127) + (mode == 2 ? 128 : 0));
#pragma unroll
    for (int jj = 0; jj < 8; ++jj) { const int n = (lane >> 3) + 8 * jj; const LAS float* s = scr + (8 * c) * CVT_P + (n ^ (4 * c));
        u32x4 o; o.x = cvt_pk_bf16(s[0 * CVT_P] * sc, s[1 * CVT_P] * sc); o.y = cvt_pk_bf16(s[2 * CVT_P] * sc, s[3 * CVT_P] * sc); o.z = cvt_pk_bf16(s[4 * CVT_P] * sc, s[5 * CVT_P] * sc); o.w = cvt_pk_bf16(s[6 * CVT_P] * sc, s[7 * CVT_P] * sc);
        *(u32x4*)(WT + (size_t)(drow0 + n) * K + k0 + 8 * c) = o; }
    LDS_WAIT(); asm volatile("" ::: "memory");
}
__device__ __forceinline__ void cvt_item8(const float* __restrict__ W, const int K, const int N, unsigned char* __restrict__ WT, const int mode, const float* __restrict__ kg, LAS float* scr, const int item, const int lane, const float wm = 64.f) {
    const int nblk = N >> 6, kb = item / nblk, nb = item - kb * nblk, k0 = kb << 6, n0 = nb << 6;
    cvt_load_tile<1>(W, N, k0, n0, kg, scr, lane);
    const int c = lane & 3;
    const int drow0 = (mode == 0) ? n0 : ((n0 >> 7) * 256 + (n0 & 127) + (mode == 2 ? 128 : 0));
#pragma unroll
    for (int jj = 0; jj < 4; ++jj) { const int n = (lane >> 2) + 16 * jj; const LAS float* sp = scr + (16 * c) * CVT_P + (n ^ (8 * c));
        u32x4 o; o.x = cvt4_fp8(sp[0 * CVT_P] * wm, sp[1 * CVT_P] * wm, sp[2 * CVT_P] * wm, sp[3 * CVT_P] * wm); o.y = cvt4_fp8(sp[4 * CVT_P] * wm, sp[5 * CVT_P] * wm, sp[6 * CVT_P] * wm, sp[7 * CVT_P] * wm);
        o.z = cvt4_fp8(sp[8 * CVT_P] * wm, sp[9 * CVT_P] * wm, sp[10 * CVT_P] * wm, sp[11 * CVT_P] * wm); o.w = cvt4_fp8(sp[12 * CVT_P] * wm, sp[13 * CVT_P] * wm, sp[14 * CVT_P] * wm, sp[15 * CVT_P] * wm);
        *(u32x4*)(WT + (size_t)(drow0 + n) * K + k0 + 16 * c) = o; }
    LDS_WAIT(); asm volatile("" ::: "memory");
}
__device__ __forceinline__ void p0_weights(Frame& F) {
    asm volatile("" : "+v"(F.tid), "+v"(F.lane));
    LAS float* scr = (LAS float*)(F.lds + LDS_MAIN + F.wave * (64 * CVT_P * 4));
    constexpr int N_WIN = 4096, N_GLU = 256, N_WOUT = 2048, N_F = 6144, N_M = 3072;
    constexpr int B0 = 2 * N_WIN, B1 = B0 + 2 * N_GLU, B2 = B1 + 2 * N_WOUT, B3 = B2 + 3 * N_F;
    const int B4 = (SPEC_ATT > 0 && F.G == 256) ? B3 : B3 + 24 * N_M;
    const int B4a = (F.G == 256) ? (B4 / 100) * 94 : B4;
    for (int it0 = F.gw, second = 0;; ) {
        if (!second && it0 >= B4a) { if (F.G != 256 || (int)blockIdx.x < 128) break; second = 1; it0 = B4a + (F.gw - 128 * NWAVES); }
        if (second && it0 >= B4) break;
        const int it = it0; it0 += second ? (F.NGW - 128 * NWAVES) : F.NGW;
        int r = it;
        if (r < B0) { const int l = r / N_WIN; r -= l * N_WIN;
            if ((r % 64) / 4 >= 16 - WIN8_TILES) cvt_item8(F.in[I_WIN] + (size_t)l * DM * DIN, DM, DIN, F.WS() + WS_WIN + (size_t)l * DIN * DM * 2 + (size_t)WIN8_NF * DM, 0, F.in[I_APRE] + l * DM, scr, r, F.lane);
            else cvt_item(F.in[I_WIN] + (size_t)l * DM * DIN, DM, DIN, (bf16*)(F.WS() + WS_WIN) + (size_t)l * DIN * DM, 0, QSCALE, DSB, F.in[I_APRE] + l * DM, scr, r, F.lane);
            continue; }
        r -= B0;
        if (r < 2 * N_GLU) { const int l = r / N_GLU; r -= l * N_GLU;
            cvt_item(F.in[I_WGLU] + (size_t)l * DSSM * DSSM, DSSM, DSSM, (bf16*)(F.WS() + WS_WGLU) + (size_t)l * DSSM * DSSM, 0, 1.f, 0, nullptr, scr, r, F.lane); continue; }
        r -= 2 * N_GLU;
        if (r < 2 * N_WOUT) { const int l = r / N_WOUT; r -= l * N_WOUT;
            const float* kgo = !MERGE_FUSED ? nullptr : ((r / 64) < 16 ? F.in[I_AON] + l * DSB : F.in[I_SON] + l * DSSM - DSB);
            cvt_item(F.in[I_WOUT] + (size_t)l * DMIX * DM, DMIX, DM, (bf16*)(F.WS() + WS_WOUT) + (size_t)l * DM * DMIX, 0, 1.f, 0, kgo, scr, r, F.lane); continue; }
        r -= 2 * N_WOUT;
#if DENSE_GU_F8
        if (r < N_F) { if ((r % 96) / 2 < GU8_TILES) cvt_item8(F.in[I_FG], DM, DFF, F.WS() + WS_FGU, 1, F.in[I_FPRE], scr, r, F.lane, 64.f * GU8_WSCALE); else cvt_item(F.in[I_FG], DM, DFF, (bf16*)(F.WS() + WS_FGU), 1, 1.f, 0, F.in[I_FPRE], scr, r, F.lane); continue; }
        r -= N_F;
        if (r < N_F) { if ((r % 96) / 2 < GU8_TILES) cvt_item8(F.in[I_FU], DM, DFF, F.WS() + WS_FGU, 2, F.in[I_FPRE], scr, r, F.lane, 64.f * GU8_WSCALE); else cvt_item(F.in[I_FU], DM, DFF, (bf16*)(F.WS() + WS_FGU), 2, 1.f, 0, F.in[I_FPRE], scr, r, F.lane); continue; }
        r -= N_F;
#else
        if (r < N_F) { cvt_item(F.in[I_FG], DM, DFF, (bf16*)(F.WS() + WS_FGU), 1, 1.f, 0, F.in[I_FPRE], scr, r, F.lane); continue; }
        r -= N_F;
        if (r < N_F) { cvt_item(F.in[I_FU], DM, DFF, (bf16*)(F.WS() + WS_FGU), 2, 1.f, 0, F.in[I_FPRE], scr, r, F.lane); continue; }
        r -= N_F;
#endif
#if DENSE_DOWN_F8
        if (r < N_F) { cvt_item8(F.in[I_FD], DFF, DM, F.WS() + WS_FDN, 0, nullptr, scr, r, F.lane); continue; }
#else
        if (r < N_F) { cvt_item(F.in[I_FD], DFF, DM, (bf16*)(F.WS() + WS_FDN), 0, 1.f, 0, nullptr, scr, r, F.lane); continue; }
#endif
        r -= N_F;
        { const int m = r / (8 * N_M); r -= m * (8 * N_M); const int e = r / N_M; r -= e * N_M;
          if (m == 0) cvt_item8(F.in[I_MG] + (size_t)e * DM * DFE, DM, DFE, F.WS() + WS_MGU + (size_t)e * 2 * DFE * DM, 1, F.in[I_FPRE] + DM, scr, r, F.lane);
          else if (m == 1) cvt_item8(F.in[I_MU] + (size_t)e * DM * DFE, DM, DFE, F.WS() + WS_MGU + (size_t)e * 2 * DFE * DM, 2, F.in[I_FPRE] + DM, scr, r, F.lane);
          else cvt_item8(F.in[I_MD] + (size_t)e * DFE * DM, DFE, DM, F.WS() + WS_MDN + (size_t)e * DM * DFE, 0, nullptr, scr, r, F.lane); }
    }
}
struct MoeItem { const float* W; unsigned char* WT; const float* kg; int K, N, mode, k0, n0; };
__device__ __forceinline__ void moe_item(Frame& F, const int gi, MoeItem& d) {
    constexpr int N_M = 3072; int r = gi; const int m = r / (8 * N_M); r -= m * (8 * N_M); const int e = r / N_M; r -= e * N_M;
    if (m < 2) { d.W = (m == 0 ? F.in[I_MG] : F.in[I_MU]) + (size_t)e * DM * DFE; d.K = DM; d.N = DFE; d.WT = F.WS() + WS_MGU + (size_t)e * 2 * DFE * DM; d.mode = 1 + m; d.kg = F.in[I_FPRE] + DM; }
    else { d.W = F.in[I_MD] + (size_t)e * DFE * DM; d.K = DFE; d.N = DM; d.WT = F.WS() + WS_MDN + (size_t)e * DM * DFE; d.mode = 0; d.kg = nullptr; }
    const int nblk = d.N >> 6, kb = r / nblk, nb = r - kb * nblk; d.k0 = kb << 6; d.n0 = nb << 6;
}
__device__ __forceinline__ void p0_moe(Frame& F, const int hf, const int bx) {
    asm volatile("" : "+v"(F.tid), "+v"(F.lane));
    LAS float* scr = (LAS float*)(F.lds + LDS_MAIN + F.wave * (64 * CVT_P * 4));
    constexpr int HALF_ITEMS = 12 * 3072;
    const int step = (F.G - SPEC_ATT) * NWAVES, lane = F.lane;
    int it = (bx - SPEC_ATT) * NWAVES + F.wave;
    MoeItem cur, nxt; f32x4 v[16]; float g[16];
#define MOE_ISSUE(D) do { const float* src_ = (D).W + (size_t)((D).k0 + (lane >> 4)) * (D).N + (D).n0 + (lane & 15) * 4; const float* kg_ = (D).kg ? (D).kg : F.in[I_FPRE]; \
        _Pragma("unroll") for (int i = 0; i < 16; ++i) v[i] = *(const f32x4*)(src_ + (size_t)(4 * i) * (D).N); \
        _Pragma("unroll") for (int i = 0; i < 16; ++i) g[i] = kg_[(D).k0 + 4 * i + (lane >> 4)]; __builtin_amdgcn_sched_barrier(0); } while (0)
    if (it < HALF_ITEMS) { moe_item(F, hf * HALF_ITEMS + it, cur); MOE_ISSUE(cur); }
    while (it < HALF_ITEMS) {
        const bool hg = cur.kg != nullptr;
#pragma unroll
        for (int i = 0; i < 16; ++i) *(LAS f32x4*)(scr + (4 * i + (lane >> 4)) * CVT_P + (((lane & 15) * 4) ^ (8 * (i >> 2)))) = hg ? v[i] * g[i] : v[i];
        LDS_WAIT(); asm volatile("" ::: "memory");
        const int nit = it + step;
        if (nit < HALF_ITEMS) { moe_item(F, hf * HALF_ITEMS + nit, nxt); MOE_ISSUE(nxt); }
        { const int c = lane & 3; const int n0 = cur.n0, drow0 = (cur.mode == 0) ? n0 : ((n0 >> 7) * 256 + (n0 & 127) + (cur.mode == 2 ? 128 : 0));
#pragma unroll
          for (int jj = 0; jj < 4; ++jj) { const int n = (lane >> 2) + 16 * jj; const LAS float* sp = scr + (16 * c) * CVT_P + (n ^ (8 * c));
            u32x4 o; o.x = cvt4_fp8(sp[0 * CVT_P] * 64.f, sp[1 * CVT_P] * 64.f, sp[2 * CVT_P] * 64.f, sp[3 * CVT_P] * 64.f); o.y = cvt4_fp8(sp[4 * CVT_P] * 64.f, sp[5 * CVT_P] * 64.f, sp[6 * CVT_P] * 64.f, sp[7 * CVT_P] * 64.f);
            o.z = cvt4_fp8(sp[8 * CVT_P] * 64.f, sp[9 * CVT_P] * 64.f, sp[10 * CVT_P] * 64.f, sp[11 * CVT_P] * 64.f); o.w = cvt4_fp8(sp[12 * CVT_P] * 64.f, sp[13 * CVT_P] * 64.f, sp[14 * CVT_P] * 64.f, sp[15 * CVT_P] * 64.f);
            *(u32x4*)(cur.WT + (size_t)(drow0 + n) * cur.K + cur.k0 + 16 * c) = o; }
          LDS_WAIT(); asm volatile("" ::: "memory"); }
        cur = nxt; it = nit;
    }
#undef MOE_ISSUE
}
__device__ __forceinline__ void p0_ssm(Frame& F, const int l, const int g) {
    asm volatile("" : "+v"(F.tid), "+v"(F.lane));
    LAS f32x2* pw = (LAS f32x2*)(F.lds + LDS_MAIN);
    LAS f32x2* bb = pw + 17 * 64;
    LAS f32x2* cc = bb + 64 * 16;
    LAS f32x2* fl = cc + 16 * 64;
    LAS float* Kt = (LAS float*)(fl + 64);
    const int tid = F.tid;
    __syncthreads();
    for (int e = tid; e < 17 * 64; e += 512) { const int n = e >> 6, p = e & 63;
        const float lr = fminf(F.in[I_LRE][(l * NG + g) * SP + p], -1e-4f), li = F.in[I_LIM][(l * NG + g) * SP + p], dt = expf(F.in[I_LSTEP][l * NG + g]);
        const float mag = expf((float)n * dt * lr); float s, c; sincosf((float)n * dt * li, &s, &c); const f32x2 v = {mag * c, mag * s}; pw[e] = v;
        if (n == 16) ((f32x2*)(F.WS() + WS_SSMAUX))[(l * NG + g) * SP + p] = v; }
    if (tid < 64) { const int p = tid;
        const float lr = fminf(F.in[I_LRE][(l * NG + g) * SP + p], -1e-4f), li = F.in[I_LIM][(l * NG + g) * SP + p], dt = expf(F.in[I_LSTEP][l * NG + g]);
        float s1, c1, sh, ch; sincosf(dt * li, &s1, &c1); sincosf(0.5f * dt * li, &sh, &ch);
        const float em1 = expm1f(dt * lr), mag = em1 + 1.0f;
        const float nr = em1 * c1 - 2.0f * sh * sh, ni = mag * s1, den = lr * lr + li * li;
        fl[p] = (f32x2){(nr * lr + ni * li) / den, (ni * lr - nr * li) / den};
    }
    __syncthreads();
    for (int e = tid; e < 1024; e += 512) { const int p = e >> 4, h = e & 15; const size_t bi = ((size_t)(l * NG + g) * SP + p) * 16 + h;
        const float br = F.in[I_BRE][bi], bim = F.in[I_BIM][bi]; const f32x2 f = fl[p];
        bb[e] = (f32x2){f.x * br - f.y * bim, f.x * bim + f.y * br};
        const int h2 = e >> 6, p2 = e & 63; const size_t ci = ((size_t)(l * NG + g) * 16 + h2) * SP + p2;
        cc[e] = (f32x2){F.in[I_CRE][ci], F.in[I_CIM][ci]}; }
    __syncthreads();
    for (int e = tid; e < 4096; e += 512) { const int tau = e >> 8, h = (e >> 4) & 15, h2 = e & 15; float s = 0.f;
        for (int p = 0; p < 64; ++p) { const f32x2 a = pw[tau * 64 + p], b = bb[p * 16 + h2], c = cc[h * 64 + p];
            const float wr_ = a.x * b.x - a.y * b.y, wi_ = a.x * b.y + a.y * b.x; s += c.x * wr_ - c.y * wi_; }
        if (tau == 0 && h == h2) s += F.in[I_SD][l * DSSM + 16 * g + h];
        Kt[e] = s; }
    __syncthreads();
    bf16* Wm = (bf16*)(F.WS() + WS_SSMW) + (size_t)(l * NG + g) * 128 * 256;
    for (int q = tid; q < 4096; q += 512) { const int row = q >> 5, kk0 = (q & 31) * 8, j = kk0 >> 4, h0 = kk0 & 15, p = row & 63, isim = row >> 6; float v[8];
        const f32x2 a = pw[(15 - j) * 64 + p];
#pragma unroll
        for (int e = 0; e < 8; ++e) { const f32x2 b = bb[p * 16 + h0 + e]; v[e] = isim ? (a.x * b.y + a.y * b.x) : (a.x * b.x - a.y * b.y); }
        const u32x4 w = {cvt_pk_bf16(v[0], v[1]), cvt_pk_bf16(v[2], v[3]), cvt_pk_bf16(v[4], v[5]), cvt_pk_bf16(v[6], v[7])};
        *(u32x4*)(Wm + ((size_t)((row >> 5) * 16 + (kk0 >> 4)) * 64 + ((kk0 >> 3) & 1) * 32 + (row & 31)) * 8) = w; }
    bf16* TM = (bf16*)(F.WS() + WS_SSMTM) + (size_t)(l * NG + g) * 256 * 384;
    for (int q = tid; q < 256 * 48; q += 512) { const int row = q / 48, pk = q - row * 48, kk0 = pk * 8, i = row >> 4, h = row & 15; float v[8];
        if (kk0 < 256) { const int j = kk0 >> 4, h0 = kk0 & 15;
#pragma unroll
            for (int e = 0; e < 8; ++e) v[e] = (j <= i) ? Kt[((i - j) * 16 + h) * 16 + h0 + e] : 0.f;
        } else { const int sidx = kk0 - 256, isim = sidx >> 6, p0 = sidx & 63;
#pragma unroll
            for (int e = 0; e < 8; ++e) { const f32x2 c = cc[h * 64 + p0 + e], a = pw[(i + 1) * 64 + p0 + e]; v[e] = isim ? -(c.x * a.y + c.y * a.x) : (c.x * a.x - c.y * a.y); } }
        const u32x4 w = {cvt_pk_bf16(v[0], v[1]), cvt_pk_bf16(v[2], v[3]), cvt_pk_bf16(v[4], v[5]), cvt_pk_bf16(v[6], v[7])};
        *(u32x4*)(TM + ((size_t)((row >> 5) * 24 + (kk0 >> 4)) * 64 + ((kk0 >> 3) & 1) * 32 + (row & 31)) * 8) = w; }
    __syncthreads();
}

typedef __amdgpu_buffer_rsrc_t rsrc_t;
__device__ __forceinline__ rsrc_t mk_rsrc(const void* p, unsigned bytes) { return __builtin_amdgcn_make_buffer_rsrc(const_cast<void*>(p), 0, bytes, 0x00020000); }
__device__ __forceinline__ f32x4 bld_f4(rsrc_t r, int voff, int soff) { return __builtin_bit_cast(f32x4, __builtin_amdgcn_raw_buffer_load_b128(r, voff, soff, 0)); }
__device__ __forceinline__ u32x2 bld_u2(rsrc_t r, int voff, int soff) { return __builtin_amdgcn_raw_buffer_load_b64(r, voff, soff, 0); }
__device__ __forceinline__ void bst_f4(f32x4 v, rsrc_t r, int voff, int soff) { __builtin_amdgcn_raw_buffer_store_b128(__builtin_bit_cast(u32x4, v), r, voff, soff, 0); }
__device__ __forceinline__ void bst_u2(u32x2 v, rsrc_t r, int voff, int soff) { __builtin_amdgcn_raw_buffer_store_b64(v, r, voff, soff, 0); }
constexpr unsigned ROWF = DM * 4, ROWH = DM * 2;
__device__ __forceinline__ void pass_norm0(Frame& F) {
    asm volatile("" : "+v"(F.tid), "+v"(F.lane));
    const rsrc_t rx = mk_rsrc(F.in[I_X], (unsigned)T_ * ROWF), rn = mk_rsrc(F.WS() + WS_HN, (unsigned)T_ * ROWH), r8w = mk_rsrc(F.WS() + WS_H8W, (unsigned)T_ * DM);
    float* RS = (float*)(F.WS() + WS_RS);
    const int v16 = F.lane * 16, v8 = F.lane * 8;
    for (int row = F.gw; row < T_; row += F.NGW) {
        f32x4 v[16]; float ss = 0.f;
#pragma unroll
        for (int j = 0; j < 16; ++j) { v[j] = bld_f4(rx, v16, row * (int)ROWF + j * 1024); }
#pragma unroll
        for (int j = 0; j < 16; ++j) ss += v[j][0] * v[j][0] + v[j][1] * v[j][1] + v[j][2] * v[j][2] + v[j][3] * v[j][3];
        const float rs = rsqrtf(wave_sum(ss) * (1.0f / DM) + RMS_EPS);
#pragma unroll
        for (int j = 0; j < 16; ++j) { const u32x2 w = {cvt_pk_bf16(v[j][0], v[j][1]), cvt_pk_bf16(v[j][2], v[j][3])}; bst_u2(w, rn, v8, row * (int)ROWH + j * 512); }
        if (WIN8_TILES > 0) {
#pragma unroll
            for (int j = 0; j < 16; ++j) __builtin_amdgcn_raw_buffer_store_b32(cvt4_fp8(v[j][0], v[j][1], v[j][2], v[j][3]), r8w, F.lane * 4, row * DM + j * 256, 0); }
        if (F.lane == 0) RS[row] = rs;
    }
}
__device__ __forceinline__ void pass_merge(Frame& F, const int l) {
    asm volatile("" : "+v"(F.tid), "+v"(F.lane));
    const bf16* AO = (const bf16*)(F.WS() + WS_ATTO); const bf16* SO = (const bf16*)(F.WS() + WS_SSMO); bf16* MG = (bf16*)(F.WS() + WS_MERGED);
    for (int row = F.gw; row < T_; row += F.NGW) {
#pragma unroll
        for (int part = 0; part < 2; ++part) {
            const bf16* src = (part ? SO : AO) + (size_t)row * 1024 + 8 * F.lane; const float* gain = F.in[part ? I_SON : I_AON] + l * 1024 + 8 * F.lane;
            u32x4 w[2]; float v[16]; float ss = 0.f;
#pragma unroll
            for (int j = 0; j < 2; ++j) { w[j] = *(const u32x4*)(src + 512 * j);
                v[8 * j + 0] = bf_lo(w[j].x); v[8 * j + 1] = bf_hi(w[j].x); v[8 * j + 2] = bf_lo(w[j].y); v[8 * j + 3] = bf_hi(w[j].y);
                v[8 * j + 4] = bf_lo(w[j].z); v[8 * j + 5] = bf_hi(w[j].z); v[8 * j + 6] = bf_lo(w[j].w); v[8 * j + 7] = bf_hi(w[j].w); }
#pragma unroll
            for (int k = 0; k < 16; ++k) ss += v[k] * v[k];
            const float rs = rsqrtf(wave_sum(ss) * (1.0f / 1024.0f) + RMS_EPS);
            bf16* dst = MG + (size_t)row * DMIX + part * 1024 + 8 * F.lane;
#pragma unroll
            for (int j = 0; j < 2; ++j) { const f32x4 g0 = *(const f32x4*)(gain + 512 * j), g1 = *(const f32x4*)(gain + 512 * j + 4);
                const u32x4 o = {cvt_pk_bf16(v[8 * j + 0] * rs * g0[0], v[8 * j + 1] * rs * g0[1]), cvt_pk_bf16(v[8 * j + 2] * rs * g0[2], v[8 * j + 3] * rs * g0[3]),
                                 cvt_pk_bf16(v[8 * j + 4] * rs * g1[0], v[8 * j + 5] * rs * g1[1]), cvt_pk_bf16(v[8 * j + 6] * rs * g1[2], v[8 * j + 7] * rs * g1[3])};
                *(u32x4*)(dst + 512 * j) = o; }
        }
    }
}
__device__ __forceinline__ void pass_mix_row(Frame& F, const int l, const int dry, const u32x2 (&hw)[16], const u32x2 (&mv)[16], const int row,
                                             const rsrc_t rw, const rsrc_t r8, const rsrc_t rgp, float* RS, const int v16, const int v8) {

        f32x4 hv[16]; float ss = 0.f;
#pragma unroll
        for (int j = 0; j < 16; ++j) { const float a = bf_lo(mv[j].x), b = bf_hi(mv[j].x), c = bf_lo(mv[j].y), d = bf_hi(mv[j].y); ss += a * a + b * b + c * c + d * d; }
        const float rs = rsqrtf(wave_sum(ss) * (1.0f / DM) + RMS_EPS);
        float s2 = 0.f;
        float lg[8] = {0.f, 0.f, 0.f, 0.f, 0.f, 0.f, 0.f, 0.f};
#pragma unroll
        for (int j = 0; j < 16; ++j) { const f32x4 g = bld_f4(rgp, v16, j * 1024);
            hv[j][0] = bf_lo(hw[j].x) + bf_lo(mv[j].x) * rs * g[0]; hv[j][1] = bf_hi(hw[j].x) + bf_hi(mv[j].x) * rs * g[1]; hv[j][2] = bf_lo(hw[j].y) + bf_lo(mv[j].y) * rs * g[2]; hv[j][3] = bf_hi(hw[j].y) + bf_hi(mv[j].y) * rs * g[3];
            s2 += hv[j][0] * hv[j][0] + hv[j][1] * hv[j][1] + hv[j][2] * hv[j][2] + hv[j][3] * hv[j][3]; }
        const float rs2 = rsqrtf(wave_sum(s2) * (1.0f / DM) + RMS_EPS);
#pragma unroll
        for (int j = 0; j < 16; ++j) { const u32x2 w = {cvt_pk_bf16(hv[j][0], hv[j][1]), cvt_pk_bf16(hv[j][2], hv[j][3])}; bst_u2(w, rw, v8, row * (int)ROWH + j * 512); }
        if (F.lane == 0) RS[row + (dry ? T_ : 0)] = rs2;
        if (l == 1 || DENSE_GU_F8) {
#pragma unroll
            for (int j = 0; j < 16; ++j) { const float s8 = (l == 0) ? GU8_ASCALE : 1.0f; __builtin_amdgcn_raw_buffer_store_b32(cvt4_fp8(hv[j][0] * s8, hv[j][1] * s8, hv[j][2] * s8, hv[j][3] * s8), r8, F.lane * 4, row * DM + j * 256, 0); }
        }
        if (l == 1) {
#pragma unroll
            for (int j = 0; j < 16; ++j) {
                unsigned rjo = (unsigned)(j * 8192) + (unsigned)v16; asm volatile("" : "+v"(rjo));
                const LAS f32x4* rj = (const LAS f32x4*)(F.lds + LDS_MAIN + rjo);
#pragma unroll
                for (int i = 0; i < 4; ++i) { const f32x4 r0 = rj[(i * 2 + 0) * 64], r1 = rj[(i * 2 + 1) * 64]; const float hk = hv[j][i];
                    lg[0] += hk * r0[0]; lg[1] += hk * r0[1]; lg[2] += hk * r0[2]; lg[3] += hk * r0[3]; lg[4] += hk * r1[0]; lg[5] += hk * r1[1]; lg[6] += hk * r1[2]; lg[7] += hk * r1[3]; }
            }
#pragma unroll
            for (int e = 0; e < 8; ++e) lg[e] = wave_sum(lg[e]) * rs2;
            int e1 = 0; float l1 = lg[0];
#pragma unroll
            for (int e = 1; e < 8; ++e) if (lg[e] > l1) { l1 = lg[e]; e1 = e; }
            int e2 = -1; float l2 = -INFINITY;
#pragma unroll
            for (int e = 0; e < 8; ++e) if (e != e1 && (e2 < 0 || lg[e] > l2)) { l2 = lg[e]; e2 = e; }
            const float w = __expf(l2 - l1), g1 = 1.0f / (1.0f + w), g2 = w / (1.0f + w);
            if (F.lane == 0) {
                const int s1 = (int)__hip_atomic_fetch_add(F.CTL() + CW_CUR + 64 * e1, 1u, RLX_AGENT);
                const int sl2 = (int)__hip_atomic_fetch_add(F.CTL() + CW_CUR + 64 * e2, 1u, RLX_AGENT);
                i32x2* list = (i32x2*)(F.WS() + WS_LIST);
                list[(size_t)e1 * LIST_CAP + s1] = (i32x2){row, __float_as_int(g1)};
                list[(size_t)e2 * LIST_CAP + sl2] = (i32x2){row, __float_as_int(g2)};
                ((i32x4*)(F.WS() + WS_POS))[row] = (i32x4){e1, s1, e2, sl2};
            }
        }
}
__device__ __forceinline__ void pass_mix(Frame& F, const int l, const int dry = 0) {
    asm volatile("" : "+v"(F.tid), "+v"(F.lane));
    const float* gpre = F.in[I_FPRE] + l * DM;
    const rsrc_t rw = mk_rsrc(F.WS() + (dry ? WS_PROJ : WS_HN), (unsigned)T_ * ROWH);
    const rsrc_t rh = mk_rsrc(F.WS() + WS_HN, (unsigned)T_ * ROWH), rm = mk_rsrc(F.WS() + WS_MIXED, (unsigned)T_ * ROWH), r8 = mk_rsrc(F.WS() + WS_H8, (unsigned)T_ * DM);
    const rsrc_t rgp = mk_rsrc(F.in[I_APOST] + l * DM, ROWF);
    float* RS = (float*)(F.WS() + WS_RS);
    const int v16 = F.lane * 16, v8 = F.lane * 8;
    if (l == 1) {
        LAS f32x4* RL = (LAS f32x4*)(F.lds + LDS_MAIN);
        __syncthreads();
        for (int k = F.tid; k < DM; k += 512) { const int j = k >> 8, ln = (k & 255) >> 2, i = k & 3; const float g = gpre[k];
            const f32x4 r0 = *(const f32x4*)(F.in[I_RT] + (size_t)k * NE), r1 = *(const f32x4*)(F.in[I_RT] + (size_t)k * NE + 4);
            RL[((j * 4 + i) * 2 + 0) * 64 + ln] = r0 * g; RL[((j * 4 + i) * 2 + 1) * 64 + ln] = r1 * g; }
        __syncthreads();
    }
#define PM_LOAD(HW, MV, R) do { _Pragma("unroll") for (int j = 0; j < 16; ++j) { HW[j] = bld_u2(rh, v8, (R) * (int)ROWH + j * 512); MV[j] = bld_u2(rm, v8, (R) * (int)ROWH + j * 512); } __builtin_amdgcn_sched_barrier(0); } while (0)
    if (l == 0) {
        u32x2 hwA[16], mvA[16], hwB[16], mvB[16];
        if (F.gw < T_) PM_LOAD(hwA, mvA, F.gw);
        for (int row = F.gw; row < T_; row += 2 * F.NGW) {
            const int rowB = row + F.NGW, rowA2 = row + 2 * F.NGW;
            if (rowB < T_) PM_LOAD(hwB, mvB, rowB);
            pass_mix_row(F, 0, dry, hwA, mvA, row, rw, r8, rgp, RS, v16, v8);
            if (rowA2 < T_) PM_LOAD(hwA, mvA, rowA2);
            if (rowB < T_) pass_mix_row(F, 0, dry, hwB, mvB, rowB, rw, r8, rgp, RS, v16, v8);
        }
    } else {
        for (int row = F.gw; row < T_; row += F.NGW) { u32x2 hw[16], mv[16]; PM_LOAD(hw, mv, row); pass_mix_row(F, 1, dry, hw, mv, row, rw, r8, rgp, RS, v16, v8); }
    }
#undef PM_LOAD
}
constexpr int LDS_TAB = 131072;
__device__ __forceinline__ void moe_tiles(Frame& F, int (&ts)[9], int (&cnt)[8]) {
    int acc = 0;
#pragma unroll
    for (int e = 0; e < 8; ++e) { const int c = (int)__builtin_amdgcn_readfirstlane(__hip_atomic_load(F.CTL() + CW_CUR + 64 * e, RLX_AGENT)); cnt[e] = c; ts[e] = acc; acc += (c + 255) >> 8; }
    ts[8] = acc;
}
__device__ __forceinline__ int moe_build_table(Frame& F) {
    asm volatile("" : "+v"(F.tid), "+v"(F.lane));
    int ts[9], cnt[8]; moe_tiles(F, ts, cnt);
    LAS i32x4* tab = (LAS i32x4*)(F.lds + LDS_TAB);
    __syncthreads();
    for (int pm = F.tid; pm < ts[8]; pm += 512) { int e = 0;
#pragma unroll
        for (int k = 1; k < 8; ++k) e += (pm >= ts[k]) ? 1 : 0;
        int tse = 0, ce = 0;
#pragma unroll
        for (int k = 0; k < 8; ++k) { tse = (e == k) ? ts[k] : tse; ce = (e == k) ? cnt[k] : ce; }
        const int slot0 = (pm - tse) * 256, nv = ce - slot0; tab[pm] = (i32x4){e, slot0, nv < 256 ? nv : 256, 0}; }
    __syncthreads();
    return ts[8];
}
__device__ __forceinline__ void pass_ffn_row(Frame& F, const int l, const int dry, const u32x2 (&hw)[16], const u32x2 (&fa)[16], const u32x2 (&fb)[16], const int row,
                                             const rsrc_t rw, const rsrc_t ro, const rsrc_t rgp, float* RS, const int v16, const int v8, const rsrc_t r8w) {
    f32x4 fv[16]; float ss = 0.f;
#pragma unroll
    for (int j = 0; j < 16; ++j) {
        if (l == 0) fv[j] = (f32x4){bf_lo(fa[j].x), bf_hi(fa[j].x), bf_lo(fa[j].y), bf_hi(fa[j].y)};
        else if (MOE_Y8) {
            const auto a0 = __builtin_amdgcn_cvt_pk_f32_fp8((int)fa[j].x, false), a1 = __builtin_amdgcn_cvt_pk_f32_fp8((int)fa[j].x, true), b0 = __builtin_amdgcn_cvt_pk_f32_fp8((int)fb[j].x, false), b1 = __builtin_amdgcn_cvt_pk_f32_fp8((int)fb[j].x, true);
            fv[j] = (f32x4){(a0[0] + b0[0]) * 0.0625f, (a0[1] + b0[1]) * 0.0625f, (a1[0] + b1[0]) * 0.0625f, (a1[1] + b1[1]) * 0.0625f}; }
        else fv[j] = (f32x4){bf_lo(fa[j].x) + bf_lo(fb[j].x), bf_hi(fa[j].x) + bf_hi(fb[j].x), bf_lo(fa[j].y) + bf_lo(fb[j].y), bf_hi(fa[j].y) + bf_hi(fb[j].y)};
        ss += fv[j][0] * fv[j][0] + fv[j][1] * fv[j][1] + fv[j][2] * fv[j][2] + fv[j][3] * fv[j][3]; }
    const float rs = rsqrtf(wave_sum(ss) * (1.0f / DM) + RMS_EPS);
    float s2 = 0.f;
#pragma unroll
    for (int j = 0; j < 16; ++j) { const f32x4 g = bld_f4(rgp, v16, j * 1024);
        fv[j][0] = bf_lo(hw[j].x) + fv[j][0] * rs * g[0]; fv[j][1] = bf_hi(hw[j].x) + fv[j][1] * rs * g[1]; fv[j][2] = bf_lo(hw[j].y) + fv[j][2] * rs * g[2]; fv[j][3] = bf_hi(hw[j].y) + fv[j][3] * rs * g[3];
        s2 += fv[j][0] * fv[j][0] + fv[j][1] * fv[j][1] + fv[j][2] * fv[j][2] + fv[j][3] * fv[j][3]; }
    if (l == 0) {
        const float rs2 = rsqrtf(wave_sum(s2) * (1.0f / DM) + RMS_EPS);
#pragma unroll
        for (int j = 0; j < 16; ++j) { const u32x2 w = {cvt_pk_bf16(fv[j][0], fv[j][1]), cvt_pk_bf16(fv[j][2], fv[j][3])}; bst_u2(w, rw, v8, row * (int)ROWH + j * 512); }
        if (WIN8_TILES > 0) {
#pragma unroll
            for (int j = 0; j < 16; ++j) __builtin_amdgcn_raw_buffer_store_b32(cvt4_fp8(fv[j][0], fv[j][1], fv[j][2], fv[j][3]), r8w, F.lane * 4, row * DM + j * 256, 0); }
        if (F.lane == 0) RS[row + (dry ? T_ : 0)] = rs2;
    } else {
#pragma unroll
        for (int j = 0; j < 16; ++j) bst_f4(fv[j], ro, v16, row * (int)ROWF + j * 1024);
    }
}
__device__ __forceinline__ void pass_ffn(Frame& F, const int l, const int dry = 0) {
    asm volatile("" : "+v"(F.tid), "+v"(F.lane));
    const rsrc_t rw = mk_rsrc(F.WS() + (dry ? WS_PROJ : WS_HN), (unsigned)T_ * ROWH);
    const rsrc_t ro = mk_rsrc(F.OUT(), (unsigned)T_ * ROWF), rf = mk_rsrc(F.WS() + WS_MIXED, (unsigned)T_ * ROWH), ry = mk_rsrc(F.WS() + WS_YROWS, (unsigned)MOE_MAXROWS * (MOE_Y8 ? DM : ROWH)), rh = mk_rsrc(F.WS() + WS_HN, (unsigned)T_ * ROWH);
    const rsrc_t rgp = mk_rsrc(F.in[I_FPOST] + l * DM, ROWF), r8w = mk_rsrc(F.WS() + WS_H8W, (unsigned)T_ * DM);
    float* RS = (float*)(F.WS() + WS_RS);
    const int v16 = F.lane * 16, v8 = F.lane * 8;
    if (l == 0) {
#define PF_LOAD(HW, FA, R) do { _Pragma("unroll") for (int j = 0; j < 16; ++j) { HW[j] = bld_u2(rh, v8, (R) * (int)ROWH + j * 512); FA[j] = bld_u2(rf, v8, (R) * (int)ROWH + j * 512); } __builtin_amdgcn_sched_barrier(0); } while (0)
        u32x2 hwA[16], faA[16], hwB[16], faB[16];
        if (F.gw < T_) PF_LOAD(hwA, faA, F.gw);
        for (int row = F.gw; row < T_; row += 2 * F.NGW) {
            const int rowB = row + F.NGW, rowA2 = row + 2 * F.NGW;
            if (rowB < T_) PF_LOAD(hwB, faB, rowB);
            pass_ffn_row(F, 0, dry, hwA, faA, faA, row, rw, ro, rgp, RS, v16, v8, r8w);
            if (rowA2 < T_) PF_LOAD(hwA, faA, rowA2);
            if (rowB < T_) pass_ffn_row(F, 0, dry, hwB, faB, faB, rowB, rw, ro, rgp, RS, v16, v8, r8w);
        }
#undef PF_LOAD
    } else {
        int ts[9], cnt[8];
        moe_tiles(F, ts, cnt);
        const i32x4* POS = (const i32x4*)(F.WS() + WS_POS);
        i32x4 ps = (F.gw < T_) ? POS[F.gw] : (i32x4){0, 0, 0, 0};
        for (int row = F.gw; row < T_; row += F.NGW) {
            const int pe1 = __builtin_amdgcn_readfirstlane(ps.x), ps1 = __builtin_amdgcn_readfirstlane(ps.y), pe2 = __builtin_amdgcn_readfirstlane(ps.z), ps2 = __builtin_amdgcn_readfirstlane(ps.w);
            int t1 = 0, t2 = 0;
#pragma unroll
            for (int e = 0; e < 8; ++e) { t1 = (pe1 == e) ? ts[e] : t1; t2 = (pe2 == e) ? ts[e] : t2; }
            const int o1 = (t1 * 256 + ps1) * (int)(MOE_Y8 ? DM : ROWH), o2 = (t2 * 256 + ps2) * (int)(MOE_Y8 ? DM : ROWH);
            u32x2 hw[16], fa[16], fb[16];
#pragma unroll
            for (int j = 0; j < 16; ++j) { hw[j] = bld_u2(rh, v8, row * (int)ROWH + j * 512);
                if (MOE_Y8) { fa[j].x = (unsigned)__builtin_amdgcn_raw_buffer_load_b32(ry, F.lane * 4, o1 + j * 256, 0); fb[j].x = (unsigned)__builtin_amdgcn_raw_buffer_load_b32(ry, F.lane * 4, o2 + j * 256, 0); fa[j].y = 0u; fb[j].y = 0u; }
                else { fa[j] = bld_u2(ry, v8, o1 + j * 512); fb[j] = bld_u2(ry, v8, o2 + j * 512); } }
            const int nrow = row + F.NGW; if (nrow < T_) ps = POS[nrow];
            __builtin_amdgcn_sched_barrier(0);
            pass_ffn_row(F, 1, dry, hw, fa, fb, row, rw, ro, rgp, RS, v16, v8, r8w);
        }
    }
}

#ifndef REP_PRO
#define REP_PRO 1
#endif
#ifndef REP_GEMM
#define REP_GEMM 1
#endif
#ifndef REP_G0
#define REP_G0 1
#endif
#ifndef REP_G1
#define REP_G1 1
#endif
#ifndef REP_G2
#define REP_G2 1
#endif
#ifndef REP_G3
#define REP_G3 1
#endif
#ifndef REP_G4
#define REP_G4 1
#endif
#ifndef REP_N0
#define REP_N0 1
#endif
#ifndef REP_MIX
#define REP_MIX 1
#endif
#ifndef REP_ATT
#define REP_ATT 1
#endif
#ifndef REP_S1
#define REP_S1 1
#endif
#ifndef REP_S3
#define REP_S3 1
#endif
#ifndef PROBE_DRY
#define PROBE_DRY 0
#endif
constexpr int N_PHASES = 23;
#ifndef MK_LAUNCH_MODE
#define MK_LAUNCH_MODE 0
#endif
__global__ void __launch_bounds__(NWAVES * 64, 2) hymba_fwd(Params P) {
    extern __shared__ __attribute__((aligned(16))) unsigned char lds_raw[];
    Frame F;
    F.lds = (LAS unsigned char*)lds_raw; F.ws_ = (GAS unsigned char*)P.ws; F.ctl_ = (GAS unsigned*)(P.ws + WS_CTL); F.in = P.in; F.out_ = (GAS float*)P.out;
    F.tid = threadIdx.x; F.lane = F.tid & 63; F.wave = __builtin_amdgcn_readfirstlane(F.tid >> 6); F.G = gridDim.x;
    F.gw = blockIdx.x * NWAVES + F.wave; F.NGW = F.G * NWAVES;
    volatile LAS unsigned* MISC = (volatile LAS unsigned*)(F.lds + LDS_MISC);
    if (F.tid < 32) MISC[F.tid] = 0u;
    __syncthreads();
    const int lo = P.ph_lo, hi = P.ph_hi;
    XcdBarrier bar; bar.bar = F.CTL() + CW_BAR; bar.x = 0; bar.st = MISC + 8; bar.wave = F.wave;
    if (MK_LAUNCH_MODE == 0 || hi - lo > 1) bar = xcd_barrier_post(F.CTL() + CW_BAR, MISC + 8, F.wave);
#ifndef PHM
#define PHM 0xFFFFFFFFu
#endif
    constexpr bool ALL = (MK_LAUNCH_MODE == 0);
#define IN(k) (ALL || (lo <= (k) && (k) < hi))
#define SEAM(k) do { if (ALL ? ((k) + 1 < N_PHASES) : (IN(k) && IN((k) + 1))) xcd_barrier(bar); } while (0)
#define PHASE_FENCE() do { asm volatile("" : "+s"(F.ws_), "+s"(F.out_), "+s"(F.ctl_), "+s"(bx), "+s"(F.gw), "+s"(F.G), "+s"(F.NGW), "+s"(F.wave)); F.lane = lane_now(); F.tid = F.wave * 64 + F.lane; } while (0)
    LAS unsigned char* L0 = F.lds + LDS_MAIN;
    int bx = blockIdx.x;

    PHASE_FENCE();
    for (int rep = 0; rep < REP_PRO; ++rep) {
    if (rep) xcd_barrier(bar);
    if ((PHM & 1u) && IN(0)) {
        if (bx < 2 * NG) p0_ssm(F, bx >> 6, bx & 63);
        p0_weights(F);
        for (int rep = 0; rep < REP_N0; ++rep) pass_norm0(F);
    }
    }
    SEAM(0);
    for (int l = 0; l < 2; ++l) {
        const int pb = 1 + 11 * l;
#define HN ((bf16*)(F.WS() + WS_HN))
#define PROJ ((bf16*)(F.WS() + WS_PROJ))
#define ATTO ((bf16*)(F.WS() + WS_ATTO))
#define YB ((bf16*)(F.WS() + WS_Y))
#define SSMO ((bf16*)(F.WS() + WS_SSMO))
#define MERGED ((bf16*)(F.WS() + WS_MERGED))
#define MIXED ((bf16*)(F.WS() + WS_MIXED))
#define HID ((bf16*)(F.WS() + WS_HID))
#define SST ((float*)(F.WS() + WS_SST))
        PHASE_FENCE();
        for (int rep = 0; rep < REP_GEMM; ++rep) { if (rep) xcd_barrier(bar);
        if ((PHM & (1u << 1)) && IN(pb + 0)) {
            for (int rep_ = 0; rep_ < REP_G0; ++rep_) {
            { pg8::DenseOrder S; S.init(T_, WIN8_NF, DM, F.G, bx, HN, (const bf16*)(F.WS() + WS_WIN) + (size_t)l * DIN * DM);
              pg8::EpiStore E{PROJ, DIN, F.CTL() + CW_KMAX + 64 * l, 4, 8, (const float*)(F.WS() + WS_RS)};
              pg8::gemm_phase<pg8::EpiStore, pg8::DenseOrder, false>(L0, DM * 2, S, E, F.wave); }
            if (WIN8_TILES > 0) {
              pg8::DenseOrder S; S.init(T_, DIN - WIN8_NF, DM / 2, F.G, bx, F.WS() + WS_H8W, F.WS() + WS_WIN + (size_t)l * DIN * DM * 2 + (size_t)WIN8_NF * DM * 2);
              pg8::EpiStore E{PROJ + WIN8_NF, DIN, F.CTL() + CW_KMAX + 64 * l, 4 - (16 - WIN8_TILES), 8 - (16 - WIN8_TILES), (const float*)(F.WS() + WS_RS)};
              pg8::gemm_phase<pg8::EpiStore, pg8::DenseOrder, false, true>(L0, DM, S, E, F.wave); }
            }
        }
        }
        SEAM(pb + 0);
        for (int repm = 0; repm < REP_MIX; ++repm) { if (repm) xcd_barrier(bar);
        PHASE_FENCE();
        if ((PHM & (1u << 2)) && IN(pb + 1)) {
            const bool spec = SPEC_ATT > 0 && F.G == 256; const int na = spec ? SPEC_ATT : F.G;
            if (spec && bx >= SPEC_ATT) p0_moe(F, l, bx); else {
            const float kabs = __uint_as_float(__hip_atomic_load(F.CTL() + CW_KMAX + 64 * l, RLX_AGENT)) * 1.01f;
            for (int rep = 0; rep < REP_ATT; ++rep)
            for (int u = bx; u < 64 * NH; u += na) sba::sb_unit(PROJ, ATTO, (u >> 3) * 256, u & 7, kabs, (LAS char*)L0, F.wave, (ssq_t*)(F.WS() + WS_SS) + (size_t)(2 * l) * T_);
            for (int rep = 0; rep < REP_S1; ++rep)
            for (int b = bx; b < 256; b += na) ssm_state_item(PROJ, (const bf16*)(F.WS() + WS_SSMW) + (size_t)l * NG * 128 * 256, SST, (b & 15) * 4 + (F.wave & 3), (b >> 4) * 2 + (F.wave >> 2), F.lane);
            }
        }
        SEAM(pb + 1);
        PHASE_FENCE();
        if ((PHM & (1u << 3)) && IN(pb + 2)) { for (int it = bx; it < SCAN_ITEMS; it += F.G) ssm_scan_item(SST, (const f32x2*)(F.WS() + WS_SSMAUX) + l * NG * SP, it, (LAS char*)L0, F.tid); }
        SEAM(pb + 2);
        PHASE_FENCE();
        if ((PHM & (1u << 4)) && IN(pb + 3)) { for (int rep = 0; rep < REP_S3; ++rep) for (int b = bx; b < 256; b += F.G) ssm_out_item(PROJ, (const bf16*)(F.WS() + WS_SSMTM) + (size_t)l * NG * 256 * 384, SST, YB, (b & 15) * 4 + (F.wave & 3), (b >> 4) * 2 + (F.wave >> 2), F.lane); }
        if (repm + 1 < REP_MIX) continue;
        SEAM(pb + 3);
        }
        PHASE_FENCE();
        for (int rep = 0; rep < REP_GEMM; ++rep) { if (rep) xcd_barrier(bar);
        if ((PHM & (1u << 5)) && IN(pb + 4)) {
            pg8::DenseOrder S; S.init(T_, DSSM, DSSM, F.G, bx, YB, (const bf16*)(F.WS() + WS_WGLU) + (size_t)l * DSSM * DSSM);
            pg8::EpiGLU E{SSMO, YB, DSSM, F.in[I_BGLU] + l * DSSM, (ssq_t*)(F.WS() + WS_SS) + (size_t)(2 * l + 1) * T_};
            for (int rep_ = 0; rep_ < REP_G1; ++rep_) pg8::gemm_phase<pg8::EpiGLU, pg8::DenseOrder, false>(L0, DSSM * 2, S, E, F.wave);
        }
        }
        SEAM(pb + 4);
        if (!MERGE_FUSED) {
        PHASE_FENCE();
        if ((PHM & (1u << 6)) && IN(pb + 5)) pass_merge(F, l);
        SEAM(pb + 5);
        }
        PHASE_FENCE();
        for (int rep = 0; rep < REP_GEMM; ++rep) { if (rep) xcd_barrier(bar);
        if ((PHM & (1u << 7)) && IN(pb + 6)) {
#if MERGE_FUSED
            pg8::DenseOrder S; S.init(T_, DM, DMIX, F.G, bx, ATTO, (const bf16*)(F.WS() + WS_WOUT) + (size_t)l * DM * DMIX); S.A2 = (const char*)SSMO; S.tstepA = (size_t)pg8::BM * DSB * 2;
            pg8::EpiStoreKS E{MIXED, DM, (const ssq_t*)(F.WS() + WS_SS) + (size_t)(2 * l) * T_, (const ssq_t*)(F.WS() + WS_SS) + (size_t)(2 * l + 1) * T_};
            for (int rep_ = 0; rep_ < REP_G2; ++rep_) pg8::gemm_phase<pg8::EpiStoreKS, pg8::DenseOrder, false>(L0, DMIX * 2, S, E, F.wave);
#else
            pg8::DenseOrder S; S.init(T_, DM, DMIX, F.G, bx, MERGED, (const bf16*)(F.WS() + WS_WOUT) + (size_t)l * DM * DMIX);
            pg8::EpiStore E{MIXED, DM, nullptr, 0, 0, nullptr};
            for (int rep_ = 0; rep_ < REP_G2; ++rep_) pg8::gemm_phase<pg8::EpiStore, pg8::DenseOrder, false>(L0, DMIX * 2, S, E, F.wave);
#endif
        }
        }
        SEAM(pb + 6);
        PHASE_FENCE();
        if ((PHM & (1u << 8)) && IN(pb + 7)) { if (PROBE_DRY && l == 0) { pass_mix(F, l, 1); xcd_barrier(bar); } pass_mix(F, l); }
        SEAM(pb + 7);
        PHASE_FENCE();
        for (int rep = 0; rep < REP_GEMM; ++rep) { if (rep) xcd_barrier(bar);
        if ((PHM & (1u << 9)) && IN(pb + 8)) {
            if (l == 0) {
#if DENSE_GU_F8
                for (int rep_ = 0; rep_ < REP_G3; ++rep_) {
                { pg8::DenseOrder S; S.init(T_, GU8_TILES * 256, DM / 2, F.G, bx, F.WS() + WS_H8, F.WS() + WS_FGU);
                  pg8::EpiSwiGLU8<true> E{(unsigned char*)HID, DFF, (const float*)(F.WS() + WS_RS), 1.0f / (GU8_ASCALE * GU8_WSCALE)};
                  pg8::gemm_phase<pg8::EpiSwiGLU8<true>, pg8::DenseOrder, false, true>(L0, DM, S, E, F.wave); }
                if (GU8_TILES < 48) { pg8::DenseOrder S; S.init(T_, (48 - GU8_TILES) * 256, DM, F.G, bx, HN, (const bf16*)(F.WS() + WS_FGU) + (size_t)GU8_TILES * 256 * DM);
                  pg8::EpiSwiGLU8<true> E{(unsigned char*)HID + GU8_TILES * 128, DFF, (const float*)(F.WS() + WS_RS)};
                  pg8::gemm_phase<pg8::EpiSwiGLU8<true>, pg8::DenseOrder, false>(L0, DM * 2, S, E, F.wave); }
                }
#elif DENSE_DOWN_F8
                pg8::DenseOrder S; S.init(T_, 2 * DFF, DM, F.G, bx, HN, (const bf16*)(F.WS() + WS_FGU));
                pg8::EpiSwiGLU8<true> E{(unsigned char*)HID, DFF, (const float*)(F.WS() + WS_RS)};
                for (int rep_ = 0; rep_ < REP_G3; ++rep_) pg8::gemm_phase<pg8::EpiSwiGLU8<true>, pg8::DenseOrder, false>(L0, DM * 2, S, E, F.wave);
#else
                pg8::DenseOrder S; S.init(T_, 2 * DFF, DM, F.G, bx, HN, (const bf16*)(F.WS() + WS_FGU));
                pg8::EpiSwiGLU E{HID, DFF, (const float*)(F.WS() + WS_RS)};
                for (int rep_ = 0; rep_ < REP_G3; ++rep_) pg8::gemm_phase<pg8::EpiSwiGLU, pg8::DenseOrder, false>(L0, DM * 2, S, E, F.wave);
#endif
            } else {
                pg8::MoeOrder S; S.nN = 2 * DFE / 256; S.G = F.G; S.c = bx; S.nM = moe_build_table(F); S.tab = (const LAS i32x4*)(F.lds + LDS_TAB);
                S.A = (const char*)(F.WS() + WS_H8); S.B = (const char*)(F.WS() + WS_MGU); S.tstepA = 0; S.tstepB = (size_t)256 * DM; S.estrideB = (size_t)2 * DFE * DM;
                S.list = (const i32x2*)(F.WS() + WS_LIST); S.gather = true;
                pg8::EpiSwiGLU8<false> E{(unsigned char*)HID, DFE, (const float*)(F.WS() + WS_RS)};
                for (int rep_ = 0; rep_ < REP_G3; ++rep_) pg8::gemm_phase<pg8::EpiSwiGLU8<false>, pg8::MoeOrder, true, true>(L0, DM, S, E, F.wave);
            }
        }
        }
        SEAM(pb + 8);
        PHASE_FENCE();
        for (int rep = 0; rep < REP_GEMM; ++rep) { if (rep) xcd_barrier(bar);
        if ((PHM & (1u << 10)) && IN(pb + 9)) {
            if (l == 0) {
                pg8::EpiStore E{MIXED, DM, nullptr, 0, 0, nullptr};
#if DENSE_DOWN_F8
                pg8::DenseOrder S; S.init(T_, DM, DFF / 2, F.G, bx, HID, (const bf16*)(F.WS() + WS_FDN));
                for (int rep_ = 0; rep_ < REP_G4; ++rep_) pg8::gemm_phase<pg8::EpiStore, pg8::DenseOrder, false, true>(L0, DFF, S, E, F.wave);
#else
                pg8::DenseOrder S; S.init(T_, DM, DFF, F.G, bx, HID, (const bf16*)(F.WS() + WS_FDN));
                for (int rep_ = 0; rep_ < REP_G4; ++rep_) pg8::gemm_phase<pg8::EpiStore, pg8::DenseOrder, false>(L0, DFF * 2, S, E, F.wave);
#endif
            } else {
                pg8::MoeOrder S; S.nN = DM / 256; S.G = F.G; S.c = bx; S.nM = moe_build_table(F); S.tab = (const LAS i32x4*)(F.lds + LDS_TAB);
                S.A = (const char*)HID; S.B = (const char*)(F.WS() + WS_MDN); S.tstepA = (size_t)256 * DFE; S.tstepB = (size_t)256 * DFE; S.estrideB = (size_t)DM * DFE;
                S.list = (const i32x2*)(F.WS() + WS_LIST); S.gather = false;
                pg8::EpiMoeDown E{(bf16*)(F.WS() + WS_YROWS), DM};
                for (int rep_ = 0; rep_ < REP_G4; ++rep_) pg8::gemm_phase<pg8::EpiMoeDown, pg8::MoeOrder, false, true>(L0, DFE, S, E, F.wave);
            }
        }
        }
        SEAM(pb + 9);
        PHASE_FENCE();
        if ((PHM & (1u << 11)) && IN(pb + 10)) { if (PROBE_DRY && l == 0) { pass_ffn(F, l, 1); xcd_barrier(bar); } pass_ffn(F, l); }
        SEAM(pb + 10);
    }
#undef IN
#undef SEAM
}

extern "C" void kernel_launch(void* const* d_in, const int* in_sizes, int n_in, void* d_out, int out_size, void* d_ws, size_t ws_size, hipStream_t stream) {
    static int grid = 0;
    if (grid == 0) {
        if (n_in != 26 || in_sizes[0] != T_ * DM || out_size != T_ * DM || ws_size < WS_END) {
            fprintf(stderr, "kernel_launch: shape/workspace mismatch (n_in %d, in0 %d, out %d, ws %zu < %zu); nothing launched\n", n_in, n_in > 0 ? in_sizes[0] : -1, out_size, ws_size, (size_t)WS_END); grid = -1; return; }
        int dev = 0, cus = 0, per_cu = 0;
        if (hipGetDevice(&dev) != hipSuccess || hipDeviceGetAttribute(&cus, hipDeviceAttributeMultiprocessorCount, dev) != hipSuccess) { fprintf(stderr, "kernel_launch: device query failed\n"); grid = -1; return; }
        if (hipFuncSetAttribute((const void*)hymba_fwd, hipFuncAttributeMaxDynamicSharedMemorySize, LDS_BYTES) != hipSuccess) { fprintf(stderr, "kernel_launch: hipFuncSetAttribute failed\n"); grid = -1; return; }
        if (hipOccupancyMaxActiveBlocksPerMultiprocessor(&per_cu, (const void*)hymba_fwd, NWAVES * 64, LDS_BYTES) != hipSuccess || per_cu < 1)
            fprintf(stderr, "kernel_launch: note: occupancy query reports %d workgroups per CU\n", per_cu);
        (void)hipGetLastError();
        grid = cus;
    }
    if (grid < 0) return;
    if (hipMemsetAsync((char*)d_ws + WS_CTL, 0, CTL_ZERO_BYTES, stream) != hipSuccess) { fprintf(stderr, "kernel_launch: memset failed\n"); return; }
    Params p{};
    for (int i = 0; i < 26; ++i) p.in[i] = (const float*)d_in[i];
    p.out = (float*)d_out; p.ws = (unsigned char*)d_ws;
#if MK_LAUNCH_MODE == 0
    p.ph_lo = 0; p.ph_hi = N_PHASES;
    hipLaunchKernelGGL(hymba_fwd, dim3(grid), dim3(NWAVES * 64), LDS_BYTES, stream, p);
#else
    for (int ph = 0; ph < N_PHASES; ++ph) { p.ph_lo = ph; p.ph_hi = ph + 1; hipLaunchKernelGGL(hymba_fwd, dim3(grid), dim3(NWAVES * 64), LDS_BYTES, stream, p); }
#endif
    const hipError_t le = hipPeekAtLastError();
    if (le != hipSuccess) fprintf(stderr, "kernel_launch: launch failed: %s\n", hipGetErrorName(le));
}
```

```cpp
#include <hip/hip_runtime.h>
#include <cstdio>
#include <cstdint>

#define GAS __attribute__((address_space(1)))
#define LAS __attribute__((address_space(3)))
typedef unsigned short bf16;
typedef short bf16x8 __attribute__((ext_vector_type(8)));
typedef short s16x4 __attribute__((ext_vector_type(4)));
typedef float f32x2 __attribute__((ext_vector_type(2)));
typedef float f32x4 __attribute__((ext_vector_type(4)));
typedef float f32x16 __attribute__((ext_vector_type(16)));
typedef unsigned u32x2 __attribute__((ext_vector_type(2)));
typedef unsigned u32x4 __attribute__((ext_vector_type(4)));
typedef int i32x2 __attribute__((ext_vector_type(2)));
typedef int i32x4 __attribute__((ext_vector_type(4)));

#ifndef DENSE_DOWN_F8
#define DENSE_DOWN_F8 1
#endif
#ifndef GU8_TILES
#define GU8_TILES 48
#endif
#define DENSE_GU_F8 (GU8_TILES > 0)
#ifndef GU8_ASCALE
#define GU8_ASCALE 1.0f
#endif
#ifndef GU8_WSCALE
#define GU8_WSCALE 1.0f
#endif
#ifndef SPEC_ATT
#define SPEC_ATT 128
#endif
#ifndef MOE_Y8
#define MOE_Y8 1
#endif
#ifndef MERGE_FUSED
#define MERGE_FUSED 1
#endif
#ifndef WIN8_TILES
#define WIN8_TILES 0
#endif
constexpr int T_ = 16384, DM = 4096, DIN = 4096, DSB = 1024, DSSM = 1024, DMIX = 2048, DFF = 6144, NE = 8, DFE = 3072;
constexpr int NH = 8, NG = 64, SP = 64, LCH = 16, NCH = T_ / LCH;
constexpr float RMS_EPS = 1e-6f;
constexpr float QSCALE = 0.08838834764831845f * 1.4426950408889634f;
constexpr int LIST_CAP = 16384;
constexpr int MOE_MAXROWS = 34816;

constexpr size_t MiB = 1u << 20;
constexpr size_t WS_CTL = 0, CTL_ZERO_BYTES = 131072 + 262144;
constexpr size_t WS_SS = 131072;
constexpr size_t WS_LIST = 1 * MiB;
constexpr size_t WS_POS = 2 * MiB;
constexpr size_t WS_RS = 2 * MiB + 512 * 1024;
constexpr size_t WS_SSMAUX = 3 * MiB;
constexpr size_t WS_SSMW = 4 * MiB;
constexpr size_t WS_SSMTM = 12 * MiB;
constexpr size_t WS_SST = 36 * MiB;
constexpr size_t WS_WIN = 68 * MiB;
constexpr size_t WS_WGLU = 132 * MiB;
constexpr size_t WS_WOUT = 136 * MiB;
constexpr size_t WS_FGU = 168 * MiB;
constexpr size_t WS_FDN = 264 * MiB;
constexpr size_t WS_MGU = 312 * MiB;
constexpr size_t WS_MDN = 696 * MiB;
constexpr size_t WS_HN = 888 * MiB;
constexpr size_t WS_PROJ = 1016 * MiB;
constexpr size_t WS_ATTO = 1144 * MiB;
constexpr size_t WS_Y = 1176 * MiB;
constexpr size_t WS_SSMO = 1208 * MiB;
constexpr size_t WS_MERGED = 1240 * MiB;
constexpr size_t WS_MIXED = 1304 * MiB;
constexpr size_t WS_HID = 1432 * MiB;
constexpr size_t WS_END = 1636 * MiB;
constexpr size_t WS_H8W = WS_MERGED;
constexpr size_t WS_H8 = WS_PROJ;
constexpr size_t WS_YROWS = WS_PROJ;
static_assert(WS_YROWS + (size_t)MOE_MAXROWS * DM * 2 <= WS_MIXED, "y_rows overlay");
static_assert(WS_HID + (size_t)MOE_MAXROWS * DFE * 2 <= WS_END && WS_HID + (size_t)T_ * DFF * 2 <= WS_END, "hidden");
constexpr int CW_KMAX = 64;
constexpr int CW_CUR = 256;
constexpr int CW_BAR = 4096;
constexpr int CW_BAR2 = 8192;

constexpr int LDS_MAIN = 0;
constexpr int LDS_MISC = 139264;
constexpr int LDS_BYTES = 147456;
constexpr int NWAVES = 8;

#define LDS_WAIT() asm volatile("s_waitcnt lgkmcnt(0)" ::: "memory")
#define VM_WAIT() asm volatile("s_waitcnt vmcnt(0)" ::: "memory")
#define RLX_AGENT __ATOMIC_RELAXED, __HIP_MEMORY_SCOPE_AGENT

__device__ __forceinline__ unsigned cvt_pk_bf16(float lo, float hi) { unsigned r; asm volatile("v_cvt_pk_bf16_f32 %0, %1, %2" : "=v"(r) : "v"(lo), "v"(hi)); return r; }
__device__ __forceinline__ unsigned cvt4_fp8(float a, float b, float c, float d) {
    unsigned w = 0u; w = (unsigned)__builtin_amdgcn_cvt_pk_fp8_f32(a, b, (int)w, false); w = (unsigned)__builtin_amdgcn_cvt_pk_fp8_f32(c, d, (int)w, true); return w; }
typedef unsigned ssq_t;
__device__ __forceinline__ ssq_t ss_fix(float s) { return (ssq_t)(s * 4096.0f + 0.5f); }
__device__ __forceinline__ float ss_rs(ssq_t v) { return rsqrtf((float)v * (1.0f / 4096.0f) * (1.0f / 1024.0f) + 1e-6f); }
__device__ __forceinline__ int lane_now() { int l; asm volatile("v_mbcnt_lo_u32_b32 %0, -1, 0\n\tv_mbcnt_hi_u32_b32 %0, -1, %0" : "=v"(l)); return l; }
__device__ __forceinline__ float bf_lo(unsigned w) { return __uint_as_float(w << 16); }
__device__ __forceinline__ float bf_hi(unsigned w) { return __uint_as_float(w & 0xffff0000u); }
__device__ __forceinline__ float wave_sum(float v) {
#pragma unroll
    for (int o = 1; o < 64; o <<= 1) v += __shfl_xor(v, o);
    return v;
}
__device__ __forceinline__ float wave_max(float v) {
#pragma unroll
    for (int o = 1; o < 64; o <<= 1) v = fmaxf(v, __shfl_xor(v, o));
    return v;
}
__device__ __forceinline__ float fast_sigmoid(float x) { return __builtin_amdgcn_rcpf(1.0f + __builtin_amdgcn_exp2f(-1.4426950408889634f * x)); }

namespace pg8 {
constexpr int BM = 256, BK = 64, HALF = 128, HTB = HALF * BK * 2, STAGE_BYTES = 8 * HTB, NXCD = 8, WGM = 8;
__host__ __device__ __forceinline__ int lds_byte(int r, int c) { const int st = (r >> 4) * 2 + (c >> 5), rr = r & 15, cc = c & 31, ob = rr * 64 + cc * 2; return st * 1024 + (ob ^ (((ob >> 9) & 1) << 5)); }
__host__ __device__ __forceinline__ void stage_rc(int b, int& R, int& C) { const int st = b / 1024, sb = b % 1024, swz = sb ^ (((sb >> 9) & 1) << 5); R = (st >> 1) * 16 + swz / 64; C = (st & 1) * 32 + (swz % 64) / 2; }
__host__ __device__ __forceinline__ int lds_byte8(int r, int c) { const int st = (r >> 4) * 2 + (c >> 5), rr = r & 15, cc = c & 31, ob = rr * 64 + cc * 2; return st * 1024 + (ob ^ (((ob >> 9) & 1) << 4)); }
__host__ __device__ __forceinline__ void stage_rc8(int b, int& R, int& C) { const int st = b / 1024, sb = b % 1024, swz = sb ^ (((sb >> 9) & 1) << 4); R = (st >> 1) * 16 + swz / 64; C = (st & 1) * 32 + (swz % 64) / 2; }
__host__ __device__ __forceinline__ int perm32(int rho) { const int n = rho >> 4, i = rho & 15; return 8 * (i >> 2) + 4 * n + (i & 3); }

struct Unit { int pm, pn; const char* A; const char* B; const i32x2* lst; int nvalid; const char* A2; };

__device__ __forceinline__ bool tile_of(long L, int nM, int nN, int& pm, int& pn) {
    const int nwg = nM * nN; if (L >= nwg) return false;
    int wgid = (int)L; { const int q = nwg / NXCD, r = nwg % NXCD, xcd = wgid % NXCD, off = wgid / NXCD; wgid = (xcd < r ? xcd * (q + 1) : r * (q + 1) + (xcd - r) * q) + off; }
    const int nig = WGM * nN, gid = wgid / nig, fm = gid * WGM, gsz = (nM - fm) < WGM ? (nM - fm) : WGM;
    pm = fm + ((wgid % nig) % gsz); pn = (wgid % nig) / gsz; return true;
}
struct DenseOrder {
    int nM, nN, G, c; const char* A; const char* B; size_t tstepA, tstepB; const char* A2 = nullptr;
    __device__ __forceinline__ void init(int M, int N, int K, int G_, int c_, const void* A_, const void* B_) { nM = M / BM; nN = N / BM; G = G_; c = c_; A = (const char*)A_; B = (const char*)B_; tstepA = tstepB = (size_t)BM * K * 2; }
    __device__ __forceinline__ bool next(int i, Unit& u) const {
        if (!tile_of((long)i * G + c, nM, nN, u.pm, u.pn)) return false;
        u.A = A + (size_t)u.pm * tstepA; u.A2 = A2 + (size_t)u.pm * tstepA; u.B = B + (size_t)u.pn * tstepB; u.lst = nullptr; u.nvalid = BM; return true; }
};
struct MoeOrder {
    int nM, nN, G, c; const LAS i32x4* tab; const char* A; const char* B; size_t tstepA, tstepB, estrideB; const i32x2* list; bool gather;
    __device__ __forceinline__ bool next(int i, Unit& u) const {
        if (!tile_of((long)i * G + c, nM, nN, u.pm, u.pn)) return false;
        const i32x4 t = tab[u.pm];
        const int e = __builtin_amdgcn_readfirstlane(t.x), slot0 = __builtin_amdgcn_readfirstlane(t.y);
        u.nvalid = __builtin_amdgcn_readfirstlane(t.z);
        u.lst = list + (size_t)e * LIST_CAP + slot0;
        u.A = gather ? A : A + (size_t)u.pm * tstepA; u.A2 = nullptr; u.B = B + (size_t)e * estrideB + (size_t)u.pn * tstepB; return true; }
};

struct EpiStore {
    static constexpr bool PERM = true; static constexpr bool KSPLIT = false;
    bf16* O; int ldc; unsigned* kmax; int kpn_lo, kpn_hi; const float* rs;
    __device__ __forceinline__ void operator()(const f32x4 (&acc)[2][2][4][2], const Unit& u, int wr, int wc, int fr, int fq) const {
        const int row0 = u.pm * BM + wr * 64 + fr, col0 = u.pn * BM + wc * 32 + 8 * fq;
        float mx = 0.f;
        float scv[2][4];
#pragma unroll
        for (int ai = 0; ai < 2; ++ai)
#pragma unroll
            for (int m = 0; m < 4; ++m) scv[ai][m] = rs ? rs[row0 + ai * HALF + m * 16] : 1.0f;
        __builtin_amdgcn_sched_barrier(0);
#pragma unroll
        for (int ai = 0; ai < 2; ++ai)
#pragma unroll
            for (int m = 0; m < 4; ++m) { const int row = row0 + ai * HALF + m * 16; bf16* rowp = O + (size_t)row * ldc + col0; const float sc = scv[ai][m];
#pragma unroll
                for (int bj = 0; bj < 2; ++bj) { const f32x4 v0 = acc[ai][bj][m][0] * sc, v1 = acc[ai][bj][m][1] * sc;
                    mx = fmaxf(mx, fmaxf(fmaxf(fmaxf(fabsf(v0[0]), fabsf(v0[1])), fmaxf(fabsf(v0[2]), fabsf(v0[3]))), fmaxf(fmaxf(fabsf(v1[0]), fabsf(v1[1])), fmaxf(fabsf(v1[2]), fabsf(v1[3])))));
                    u32x4 w; w.x = cvt_pk_bf16(v0[0], v0[1]); w.y = cvt_pk_bf16(v0[2], v0[3]); w.z = cvt_pk_bf16(v1[0], v1[1]); w.w = cvt_pk_bf16(v1[2], v1[3]);
                    *(u32x4*)(rowp + bj * HALF) = w; } }
        if (kmax != nullptr && u.pn >= kpn_lo && u.pn < kpn_hi) {
            mx = wave_max(mx);
            if (lane_now() == 0) __hip_atomic_fetch_max(kmax, __float_as_uint(mx), RLX_AGENT);
        }
    }
};
struct EpiStoreKS {
    static constexpr bool PERM = true; static constexpr bool KSPLIT = true;
    bf16* O; int ldc; const ssq_t* ssa; const ssq_t* sss;
    __device__ __forceinline__ void ratios(float (&rat)[2][4], const Unit& u, int wr, int fr) const {
        const __amdgpu_buffer_rsrc_t ra = __builtin_amdgcn_make_buffer_rsrc(const_cast<ssq_t*>(ssa), 0, T_ * 4, 0x00020000), rb = __builtin_amdgcn_make_buffer_rsrc(const_cast<ssq_t*>(sss), 0, T_ * 4, 0x00020000);
        const int vo = (wr * 64 + fr) * 4, so = u.pm * BM * 4;
#pragma unroll
        for (int ai = 0; ai < 2; ++ai)
#pragma unroll
            for (int m = 0; m < 4; ++m) { const ssq_t a = (ssq_t)__builtin_amdgcn_raw_buffer_load_b32(ra, vo + (ai * HALF + m * 16) * 4, so, 0), b = (ssq_t)__builtin_amdgcn_raw_buffer_load_b32(rb, vo + (ai * HALF + m * 16) * 4, so, 0);
                rat[ai][m] = ss_rs(a) / ss_rs(b); }
    }
    __device__ __forceinline__ void operator()(const f32x4 (&acc)[2][2][4][2], const Unit& u, int wr, int wc, int fr, int fq) const {
        const int row0 = u.pm * BM + wr * 64 + fr, col0 = u.pn * BM + wc * 32 + 8 * fq;
        const __amdgpu_buffer_rsrc_t rb = __builtin_amdgcn_make_buffer_rsrc(const_cast<ssq_t*>(sss), 0, T_ * 4, 0x00020000);
        const int vo = (wr * 64 + fr) * 4, so = u.pm * BM * 4;
        ssq_t b[2][4];
#pragma unroll
        for (int ai = 0; ai < 2; ++ai)
#pragma unroll
            for (int m = 0; m < 4; ++m) b[ai][m] = (ssq_t)__builtin_amdgcn_raw_buffer_load_b32(rb, vo + (ai * HALF + m * 16) * 4, so, 0);
        __builtin_amdgcn_sched_barrier(0);
#pragma unroll
        for (int ai = 0; ai < 2; ++ai)
#pragma unroll
            for (int m = 0; m < 4; ++m) { const int row = row0 + ai * HALF + m * 16; bf16* rowp = O + (size_t)row * ldc + col0; const float sc = ss_rs(b[ai][m]);
#pragma unroll
                for (int bj = 0; bj < 2; ++bj) { const f32x4 v0 = acc[ai][bj][m][0] * sc, v1 = acc[ai][bj][m][1] * sc;
                    u32x4 w; w.x = cvt_pk_bf16(v0[0], v0[1]); w.y = cvt_pk_bf16(v0[2], v0[3]); w.z = cvt_pk_bf16(v1[0], v1[1]); w.w = cvt_pk_bf16(v1[2], v1[3]);
                    *(u32x4*)(rowp + bj * HALF) = w; } }
    }
};
struct EpiSwiGLU {
    static constexpr bool PERM = true; static constexpr bool KSPLIT = false;
    bf16* O; int ldc; const float* rs;
    __device__ __forceinline__ void operator()(const f32x4 (&acc)[2][2][4][2], const Unit& u, int wr, int wc, int fr, int fq) const {
        const int row0 = u.pm * BM + wr * 64 + fr, col0 = u.pn * HALF + wc * 32 + 8 * fq;
        float scv[2][4];
#pragma unroll
        for (int ai = 0; ai < 2; ++ai)
#pragma unroll
            for (int m = 0; m < 4; ++m) scv[ai][m] = rs[row0 + ai * HALF + m * 16];
        __builtin_amdgcn_sched_barrier(0);
#pragma unroll
        for (int ai = 0; ai < 2; ++ai)
#pragma unroll
            for (int m = 0; m < 4; ++m) { const int row = row0 + ai * HALF + m * 16; bf16* rowp = O + (size_t)row * ldc + col0; const float sc = scv[ai][m];
                float h[8];
#pragma unroll
                for (int n = 0; n < 2; ++n)
#pragma unroll
                    for (int j = 0; j < 4; ++j) { const float g = acc[ai][0][m][n][j] * sc, up = acc[ai][1][m][n][j] * sc; h[n * 4 + j] = g * fast_sigmoid(g) * up; }
                u32x4 w; w.x = cvt_pk_bf16(h[0], h[1]); w.y = cvt_pk_bf16(h[2], h[3]); w.z = cvt_pk_bf16(h[4], h[5]); w.w = cvt_pk_bf16(h[6], h[7]);
                *(u32x4*)rowp = w; }
    }
};
template <bool DIRECT> struct EpiSwiGLU8 {
    static constexpr bool PERM = true; static constexpr bool KSPLIT = false;
    unsigned char* O; int ldc; const float* rs; float mul = 1.0f;
    __device__ __forceinline__ void operator()(const f32x4 (&acc)[2][2][4][2], const Unit& u, int wr, int wc, int fr, int fq) const {
        const int r0 = wr * 64 + fr, row0 = u.pm * BM + r0, col0 = u.pn * HALF + wc * 32 + 8 * fq;
        int tkv[2][4]; float scv[2][4];
#pragma unroll
        for (int ai = 0; ai < 2; ++ai)
#pragma unroll
            for (int m = 0; m < 4; ++m) { const int rl = r0 + ai * HALF + m * 16; if constexpr (DIRECT) tkv[ai][m] = row0 + ai * HALF + m * 16; else tkv[ai][m] = u.lst[rl < u.nvalid ? rl : 0].x; }
        __builtin_amdgcn_sched_barrier(0);
#pragma unroll
        for (int ai = 0; ai < 2; ++ai)
#pragma unroll
            for (int m = 0; m < 4; ++m) scv[ai][m] = rs[tkv[ai][m]];
        __builtin_amdgcn_sched_barrier(0);
#pragma unroll
        for (int ai = 0; ai < 2; ++ai)
#pragma unroll
            for (int m = 0; m < 4; ++m) { const int rl = r0 + ai * HALF + m * 16; unsigned char* rowp = O + (size_t)(row0 + ai * HALF + m * 16) * ldc + col0;
                const float sc = (DIRECT || rl < u.nvalid) ? scv[ai][m] * mul : 0.f;
                float h[8];
#pragma unroll
                for (int n = 0; n < 2; ++n)
#pragma unroll
                    for (int j = 0; j < 4; ++j) { const float g = acc[ai][0][m][n][j] * sc, up = acc[ai][1][m][n][j] * sc; h[n * 4 + j] = g * fast_sigmoid(g) * up; }
                const u32x2 w = {cvt4_fp8(h[0], h[1], h[2], h[3]), cvt4_fp8(h[4], h[5], h[6], h[7])};
                *(u32x2*)rowp = w; }
    }
};
struct EpiGLU {
    static constexpr bool PERM = true; static constexpr bool KSPLIT = false;
    bf16* O; const bf16* Y; int ldc; const float* bias; ssq_t* ss;
    __device__ __forceinline__ void operator()(const f32x4 (&acc)[2][2][4][2], const Unit& u, int wr, int wc, int fr, int fq) const {
        const int row0 = u.pm * BM + wr * 64 + fr, col0 = u.pn * BM + wc * 32 + 8 * fq;
        f32x4 bv[2][2];
#pragma unroll
        for (int bj = 0; bj < 2; ++bj)
#pragma unroll
            for (int n = 0; n < 2; ++n) bv[bj][n] = *(const f32x4*)(bias + col0 + bj * HALF + 4 * n);
#pragma unroll
        for (int ai = 0; ai < 2; ++ai) {
        u32x4 yvv[4][2];
#pragma unroll
            for (int m = 0; m < 4; ++m)
#pragma unroll
                for (int bj = 0; bj < 2; ++bj) yvv[m][bj] = *(const u32x4*)(Y + (size_t)(row0 + ai * HALF + m * 16) * ldc + col0 + bj * HALF);
        __builtin_amdgcn_sched_barrier(0);
#pragma unroll
            for (int m = 0; m < 4; ++m) { const size_t off = (size_t)(row0 + ai * HALF + m * 16) * ldc + col0; float sq = 0.f;
#pragma unroll
                for (int bj = 0; bj < 2; ++bj) { const u32x4 yv = yvv[m][bj];
                    const f32x4 v0 = acc[ai][bj][m][0] + bv[bj][0], v1 = acc[ai][bj][m][1] + bv[bj][1];
                    u32x4 w;
                    w.x = cvt_pk_bf16(bf_lo(yv.x) * fast_sigmoid(v0[0]), bf_hi(yv.x) * fast_sigmoid(v0[1]));
                    w.y = cvt_pk_bf16(bf_lo(yv.y) * fast_sigmoid(v0[2]), bf_hi(yv.y) * fast_sigmoid(v0[3]));
                    w.z = cvt_pk_bf16(bf_lo(yv.z) * fast_sigmoid(v1[0]), bf_hi(yv.z) * fast_sigmoid(v1[1]));
                    w.w = cvt_pk_bf16(bf_lo(yv.w) * fast_sigmoid(v1[2]), bf_hi(yv.w) * fast_sigmoid(v1[3]));
                    *(u32x4*)(O + off + bj * HALF) = w;
                    if (MERGE_FUSED) { sq += bf_lo(w.x) * bf_lo(w.x) + bf_hi(w.x) * bf_hi(w.x) + bf_lo(w.y) * bf_lo(w.y) + bf_hi(w.y) * bf_hi(w.y) + bf_lo(w.z) * bf_lo(w.z) + bf_hi(w.z) * bf_hi(w.z) + bf_lo(w.w) * bf_lo(w.w) + bf_hi(w.w) * bf_hi(w.w); } }
                if (MERGE_FUSED && ss != nullptr) { sq += __shfl_xor(sq, 16); sq += __shfl_xor(sq, 32);
                    if (fq == 0) __hip_atomic_fetch_add(ss + row0 + ai * HALF + m * 16, ss_fix(sq), RLX_AGENT); } }
        __builtin_amdgcn_sched_barrier(0);
        }
    }
};
struct EpiMoeDown {
    static constexpr bool PERM = true; static constexpr bool KSPLIT = false;
    bf16* O; int ldc;
    __device__ __forceinline__ void operator()(const f32x4 (&acc)[2][2][4][2], const Unit& u, int wr, int wc, int fr, int fq) const {
        const int r0 = wr * 64 + fr, row0 = u.pm * BM + r0, col0 = u.pn * BM + wc * 32 + 8 * fq;
        float gtv[2][4];
#pragma unroll
        for (int ai = 0; ai < 2; ++ai)
#pragma unroll
            for (int m = 0; m < 4; ++m) { const int rl = r0 + ai * HALF + m * 16; const float gl = __int_as_float(u.lst[rl < u.nvalid ? rl : 0].y); gtv[ai][m] = (rl < u.nvalid) ? gl : 0.f; }
        __builtin_amdgcn_sched_barrier(0);
#pragma unroll
        for (int ai = 0; ai < 2; ++ai)
#pragma unroll
            for (int m = 0; m < 4; ++m) { const int rl = r0 + ai * HALF + m * 16;
                const float gt = gtv[ai][m];
                bf16* rowp = O + (size_t)(row0 + ai * HALF + m * 16) * ldc + col0;
#pragma unroll
                for (int bj = 0; bj < 2; ++bj) { const f32x4 v0 = acc[ai][bj][m][0] * gt, v1 = acc[ai][bj][m][1] * gt;
                    if (MOE_Y8) { const u32x2 w8 = {cvt4_fp8(v0[0] * 16.f, v0[1] * 16.f, v0[2] * 16.f, v0[3] * 16.f), cvt4_fp8(v1[0] * 16.f, v1[1] * 16.f, v1[2] * 16.f, v1[3] * 16.f)};
                        *(u32x2*)((unsigned char*)O + (size_t)(row0 + ai * HALF + m * 16) * ldc + col0 + bj * HALF) = w8; }
                    else { u32x4 w; w.x = cvt_pk_bf16(v0[0], v0[1]); w.y = cvt_pk_bf16(v0[2], v0[3]); w.z = cvt_pk_bf16(v1[0], v1[1]); w.w = cvt_pk_bf16(v1[2], v1[3]);
                    *(u32x4*)(rowp + bj * HALF) = w; } } }
    }
};

typedef int i32x8 __attribute__((ext_vector_type(8)));
typedef short s16x16 __attribute__((ext_vector_type(16)));
template <class Epi, class Sched, bool GATHER, bool F8 = false>
__device__ __forceinline__ void gemm_phase(LAS unsigned char* lds, const int rowb, const Sched& S, const Epi& E, const int wave_id) {
    int lane_ = lane_now();
    const int wid = wave_id, lane = lane_, tid = wid * 64 + lane, wr = wid >> 2, wc = wid & 3, fr = lane & 15, fq = lane >> 4;
    const int nt = rowb / 128, nth = nt >> 1;
    const int rowbA = Epi::KSPLIT ? rowb / 2 : rowb;
    unsigned voffA[2], voffB[2];
#pragma unroll
    for (int i = 0; i < 2; ++i) { int R, C; if constexpr (F8) stage_rc8(tid * 16 + i * 8192, R, C); else stage_rc(tid * 16 + i * 8192, R, C); const int Rb = Epi::PERM ? ((R & ~31) + perm32(R & 31)) : R;
        voffA[i] = (unsigned)(R * rowbA + C * 2); voffB[i] = (unsigned)(Rb * rowb + C * 2); }
    const size_t kstep = (size_t)(BK * 2);
    const size_t hstep = (size_t)HALF * rowb, hstepA = (size_t)HALF * rowbA;
    const unsigned ldsw = (unsigned)wid * 1024u;
    const int aoff = F8 ? lds_byte8(wr * 64 + fr, fq * 16) : lds_byte(wr * 64 + fr, fq * 8), boff = F8 ? lds_byte8(wc * 32 + fr, fq * 16) : lds_byte(wc * 32 + fr, fq * 8);
    const int aoff1 = aoff ^ 16, boff1 = boff ^ 16;
#define PG8_SA(b, h) (((b) * 2 + (h)) * HTB)
#define PG8_SB(b, h) ((4 + (b) * 2 + (h)) * HTB)
#define PG8_GL(bufoff, gptr, i) __builtin_amdgcn_global_load_lds((const unsigned*)(gptr), (LAS unsigned*)(lds + (bufoff) + ldsw + (i) * 8192), 16, 0, 0)
#define PG8_STAGE_B(bufoff, gbase) do { PG8_GL(bufoff, (const char*)(gbase) + voffB[0], 0); PG8_GL(bufoff, (const char*)(gbase) + voffB[1], 1); } while (0)
#define PG8_STAGE_A(bufoff, kp, h, g0, g1) do { if constexpr (GATHER) { PG8_GL(bufoff, (const char*)(kp) + (g0), 0); PG8_GL(bufoff, (const char*)(kp) + (g1), 1); } \
        else { PG8_GL(bufoff, (const char*)(kp) + (h) * hstepA + voffA[0], 0); PG8_GL(bufoff, (const char*)(kp) + (h) * hstepA + voffA[1], 1); } } while (0)
#define PG8_CAT(x, y) __builtin_shufflevector(__builtin_bit_cast(i32x4, x), __builtin_bit_cast(i32x4, y), 0, 1, 2, 3, 4, 5, 6, 7)
#define PG8_LDA(dst, b, h) do { _Pragma("unroll") for (int m = 0; m < 4; ++m) { if constexpr (F8) dst##8[m] = PG8_CAT(*(const LAS bf16x8*)(lds + PG8_SA(b, h) + aoff + m * 2048), *(const LAS bf16x8*)(lds + PG8_SA(b, h) + aoff1 + m * 2048)); \
        else { _Pragma("unroll") for (int k = 0; k < 2; ++k) dst[m][k] = *(const LAS bf16x8*)(lds + PG8_SA(b, h) + aoff + m * 2048 + k * 1024); } } } while (0)
#define PG8_LDB(dst, b, h) do { _Pragma("unroll") for (int n = 0; n < 2; ++n) { if constexpr (F8) dst##8[n] = PG8_CAT(*(const LAS bf16x8*)(lds + PG8_SB(b, h) + boff + n * 2048), *(const LAS bf16x8*)(lds + PG8_SB(b, h) + boff1 + n * 2048)); \
        else { _Pragma("unroll") for (int k = 0; k < 2; ++k) dst[n][k] = *(const LAS bf16x8*)(lds + PG8_SB(b, h) + boff + n * 2048 + k * 1024); } } } while (0)
#define PG8_MMA(ai, bj, At, Bt) do { __builtin_amdgcn_s_setprio(1); _Pragma("unroll") for (int m = 0; m < 4; ++m) _Pragma("unroll") for (int n = 0; n < 2; ++n) { \
        if constexpr (F8) asm volatile("v_mfma_scale_f32_16x16x128_f8f6f4 %0, %1, %2, %0, %3, %4 op_sel_hi:[0,0,0]" : "+v"(acc[ai][bj][m][n]) : "v"(Bt##8[n]), "v"(At##8[m]), "v"(sclW), "v"(sclX)); \
        else { _Pragma("unroll") for (int k = 0; k < 2; ++k) acc[ai][bj][m][n] = __builtin_amdgcn_mfma_f32_16x16x32_bf16(Bt[n][k], At[m][k], acc[ai][bj][m][n], 0, 0, 0); } } \
        __builtin_amdgcn_s_setprio(0); } while (0)
#define PG8_WAIT_V(n) asm volatile("s_waitcnt vmcnt(" #n ")" ::: "memory")
#define PG8_WAIT_L(n) asm volatile("s_waitcnt lgkmcnt(" #n ")" ::: "memory")
#define PG8_BAR __builtin_amdgcn_s_barrier()
#define PG8_SCHED __builtin_amdgcn_sched_barrier(0)
#define PG8_GOFF(dst, u) do { _Pragma("unroll") for (int i = 0; i < 2; ++i) { int R_, C_; if constexpr (F8) stage_rc8(tid * 16 + i * 8192, R_, C_); else stage_rc(tid * 16 + i * 8192, R_, C_); _Pragma("unroll") for (int h = 0; h < 2; ++h) { const int r_ = h * HALF + R_; \
        const int tok_ = (u).lst[r_ < (u).nvalid ? r_ : 0].x; dst[h][i] = (unsigned)tok_ * (unsigned)rowb + (unsigned)(C_ * 2); } } } while (0)
    Unit cur, nxt; int ui = 0;
    if (!S.next(0, cur)) return;
    f32x4 acc[2][2][4][2];
#pragma unroll
    for (int a = 0; a < 2; ++a)
#pragma unroll
        for (int b = 0; b < 2; ++b)
#pragma unroll
            for (int m = 0; m < 4; ++m)
#pragma unroll
                for (int n = 0; n < 2; ++n) acc[a][b][m][n] = (f32x4){0.f, 0.f, 0.f, 0.f};
    bf16x8 At[4][2], B0[2][2], B1[2][2]; i32x8 At8[4], B08[2], B18[2];
    int sclW = 0x79797979, sclX = 0x7F7F7F7F; if constexpr (F8) { asm volatile("" : "+v"(sclW), "+v"(sclX)); }
    unsigned gc[2][2] = {{0u, 0u}, {0u, 0u}}, gn[2][2] = {{0u, 0u}, {0u, 0u}};
    if constexpr (GATHER) { PG8_GOFF(gc, cur); }
    const char* cA = cur.A; const char* cB = cur.B;
    PG8_STAGE_B(PG8_SB(0, 0), cB); PG8_STAGE_B(PG8_SB(0, 1), cB + hstep); PG8_STAGE_A(PG8_SA(0, 0), cA, 0, gc[0][0], gc[0][1]); PG8_STAGE_A(PG8_SA(0, 1), cA, 1, gc[1][0], gc[1][1]);
    if (wr == 1) PG8_BAR;
    PG8_WAIT_V(2); PG8_BAR;
    PG8_STAGE_B(PG8_SB(1, 0), cB + kstep); PG8_STAGE_A(PG8_SA(1, 0), cA + kstep, 0, gc[0][0], gc[0][1]); PG8_STAGE_B(PG8_SB(1, 1), cB + hstep + kstep);
    PG8_WAIT_V(6); PG8_BAR;
    for (;;) {
        const bool has_next = S.next(ui + 1, nxt);
        const char* nA = has_next ? nxt.A : cA; const char* nB = has_next ? nxt.B : cB;
        const char* cA2 = cA;
        if constexpr (Epi::KSPLIT) cA2 = cur.A2 - (size_t)nth * kstep;
        if constexpr (GATHER) { if (has_next) { PG8_GOFF(gn, nxt); } else {
#pragma unroll
            for (int h = 0; h < 2; ++h)
#pragma unroll
                for (int i = 0; i < 2; ++i) gn[h][i] = gc[h][i]; } }
        for (int t = 0; t < nt; t += 2) {
            const bool last = (t == nt - 2);
            const char* pa = (Epi::KSPLIT && t >= nth) ? cA2 : cA; const char* pa2 = (Epi::KSPLIT && t + 2 >= nth) ? cA2 : cA;
            if constexpr (Epi::KSPLIT) { if (t == nth) {
                float rat[2][4]; E.ratios(rat, cur, wr, fr);
#pragma unroll
                for (int a = 0; a < 2; ++a)
#pragma unroll
                    for (int b = 0; b < 2; ++b)
#pragma unroll
                        for (int m = 0; m < 4; ++m)
#pragma unroll
                            for (int n = 0; n < 2; ++n) acc[a][b][m][n] *= rat[a][m]; } }
            const char* a1 = pa + (size_t)(t + 1) * kstep;
            const char* a2 = last ? nA : pa2 + (size_t)(t + 2) * kstep; const char* b2 = last ? nB : cB + (size_t)(t + 2) * kstep;
            const char* a3 = a2 + kstep; const char* b3 = b2 + kstep;
            const unsigned g00 = last ? gn[0][0] : gc[0][0], g01 = last ? gn[0][1] : gc[0][1], g10 = last ? gn[1][0] : gc[1][0], g11 = last ? gn[1][1] : gc[1][1];
            PG8_LDB(B0, 0, 0); PG8_LDB(B1, 0, 1); PG8_SCHED; PG8_LDA(At, 0, 0); PG8_STAGE_A(PG8_SA(1, 1), a1, 1, gc[1][0], gc[1][1]);
            PG8_WAIT_V(8); PG8_WAIT_L(0); PG8_BAR; PG8_MMA(0, 0, At, B0); PG8_MMA(0, 1, At, B1); PG8_BAR; PG8_SCHED;
            PG8_LDA(At, 0, 1); PG8_STAGE_B(PG8_SB(0, 0), b2); PG8_STAGE_B(PG8_SB(0, 1), b2 + hstep); PG8_STAGE_A(PG8_SA(0, 0), a2, 0, g00, g01);
            PG8_WAIT_V(8); PG8_WAIT_L(0); PG8_BAR; PG8_MMA(1, 0, At, B0); PG8_MMA(1, 1, At, B1); PG8_BAR; PG8_SCHED;
            PG8_LDB(B0, 1, 0); PG8_LDB(B1, 1, 1); PG8_SCHED; PG8_LDA(At, 1, 0); PG8_STAGE_A(PG8_SA(0, 1), a2, 1, g10, g11);
            PG8_WAIT_V(8); PG8_WAIT_L(0); PG8_BAR; PG8_MMA(0, 0, At, B0); PG8_MMA(0, 1, At, B1); PG8_BAR; PG8_SCHED;
            PG8_LDA(At, 1, 1); PG8_STAGE_B(PG8_SB(1, 0), b3); PG8_STAGE_B(PG8_SB(1, 1), b3 + hstep); PG8_STAGE_A(PG8_SA(1, 0), a3, 0, g00, g01);
            PG8_WAIT_V(8); PG8_WAIT_L(0); PG8_BAR; PG8_MMA(1, 0, At, B0); PG8_MMA(1, 1, At, B1); PG8_BAR; PG8_SCHED;
        }
        if (wr == 0) PG8_BAR;
        if constexpr (F8) { asm volatile("s_nop 15\n\ts_nop 15\n\ts_nop 7" ::: "memory"); }
        E(acc, cur, wr, wc, fr, fq);
        if (!has_next) break;
#pragma unroll
        for (int a = 0; a < 2; ++a)
#pragma unroll
            for (int b = 0; b < 2; ++b)
#pragma unroll
                for (int m = 0; m < 4; ++m)
#pragma unroll
                    for (int n = 0; n < 2; ++n) acc[a][b][m][n] = (f32x4){0.f, 0.f, 0.f, 0.f};
        cur = nxt; cA = nA; cB = nB; ++ui;
        if constexpr (GATHER) {
#pragma unroll
            for (int h = 0; h < 2; ++h)
#pragma unroll
                for (int i = 0; i < 2; ++i) gc[h][i] = gn[h][i]; }
        if (wr == 1) PG8_BAR;
    }
    PG8_WAIT_V(0);
    PG8_BAR;
#undef PG8_SA
#undef PG8_SB
#undef PG8_GL
#undef PG8_STAGE_B
#undef PG8_STAGE_A
#undef PG8_LDA
#undef PG8_LDB
#undef PG8_MMA
#undef PG8_CAT
#undef PG8_WAIT_V
#undef PG8_WAIT_L
#undef PG8_BAR
#undef PG8_SCHED
#undef PG8_GOFF
}
}

namespace sba {
constexpr int SHM_T = 64 * 128 * 2;
constexpr float EXIT_THR = 160.f;
#define SBA_KSWZ(row, colB) ((row) * 256 + ((colB) ^ (((row) & 7) << 4)))
#define SBA_SBAR() __builtin_amdgcn_sched_barrier(0)
__device__ __forceinline__ int crow(int r, int hi) { return (r & 3) + 8 * (r >> 2) + 4 * hi; }
__device__ __forceinline__ void qkt(f32x16& p0, f32x16& p1, const LAS char* Ks, const bf16x8* qr, int r32, int hi) {
    p0 = f32x16{}; p1 = f32x16{};
#pragma unroll
    for (int d0 = 0; d0 < 8; ++d0) { const int cb = (d0 * 16 + hi * 8) * 2;
        const bf16x8 b0 = *(const LAS bf16x8*)(Ks + SBA_KSWZ(r32, cb));
        const bf16x8 b1 = *(const LAS bf16x8*)(Ks + SBA_KSWZ(32 + r32, cb));
        p0 = __builtin_amdgcn_mfma_f32_32x32x16_bf16(b0, qr[d0], p0, 0, 0, 0);
        p1 = __builtin_amdgcn_mfma_f32_32x32x16_bf16(b1, qr[d0], p1, 0, 0, 0); }
}
__device__ __forceinline__ int v_st(int k, int c) { const int kk = (k & ~0xC) | ((k & 4) << 1) | ((k & 8) >> 1); return ((kk >> 3) * 4 + (c >> 5)) * 512 + ((kk & 7) * 32 + (c & 31)) * 2; }
__device__ __forceinline__ int v_rd_base(int lane) { return ((lane & 3) << 3) | (((lane >> 2) & 3) << 6) | (((lane >> 4) & 1) << 5) | (((lane >> 5) & 1) << 8); }
constexpr int v_rd_off(int d0, int ks, int half) { return d0 * 512 + ks * 4096 + half * 2048; }
template <int OFF> __device__ __forceinline__ s16x4 tr_read(int vb) {
    s16x4 r; asm volatile("ds_read_b64_tr_b16 %0, %1 offset:%2" : "=&v"(r) : "v"(vb), "i"(OFF) : "memory"); return r;
}
template <int D0> __device__ __forceinline__ void pv_one(f32x16& od, int vb, bf16x8 pa0, bf16x8 pa1, bf16x8 pa2, bf16x8 pa3) {
    const s16x4 l0 = tr_read<v_rd_off(D0, 0, 0)>(vb), h0 = tr_read<v_rd_off(D0, 0, 1)>(vb), l1 = tr_read<v_rd_off(D0, 1, 0)>(vb), h1 = tr_read<v_rd_off(D0, 1, 1)>(vb);
    const s16x4 l2 = tr_read<v_rd_off(D0, 2, 0)>(vb), h2 = tr_read<v_rd_off(D0, 2, 1)>(vb), l3 = tr_read<v_rd_off(D0, 3, 0)>(vb), h3 = tr_read<v_rd_off(D0, 3, 1)>(vb);
    asm volatile("s_waitcnt lgkmcnt(0)" ::: "memory"); SBA_SBAR();
#define SBA_PK(L, H) (bf16x8){L[0], L[1], L[2], L[3], H[0], H[1], H[2], H[3]}
    od = __builtin_amdgcn_mfma_f32_32x32x16_bf16(pa0, SBA_PK(l0, h0), od, 0, 0, 0);
    od = __builtin_amdgcn_mfma_f32_32x32x16_bf16(pa1, SBA_PK(l1, h1), od, 0, 0, 0);
    od = __builtin_amdgcn_mfma_f32_32x32x16_bf16(pa2, SBA_PK(l2, h2), od, 0, 0, 0);
    od = __builtin_amdgcn_mfma_f32_32x32x16_bf16(pa3, SBA_PK(l3, h3), od, 0, 0, 0);
#undef SBA_PK
}
__device__ __forceinline__ float partner32(float x, const int hi) {
    const auto rr = __builtin_amdgcn_permlane32_swap(__float_as_uint(x), __float_as_uint(x), false, false);
    return hi ? __uint_as_float(rr[0]) : __uint_as_float(rr[1]);
}
__device__ __forceinline__ float sp2(float x) { const float r = __builtin_amdgcn_logf(1.0f + __builtin_amdgcn_exp2f(x)); return x > 30.f ? x : r; }

__device__ __forceinline__ void sb_unit(const bf16* __restrict__ proj, bf16* __restrict__ out, const int t0, const int h, const float kabs, LAS char* lds, const int wave_id, ssq_t* ssrow) {
    int lane_ = lane_now();
    const int wid = wave_id, lane = lane_, tid = wid * 64 + lane, r32 = lane & 31, hi = lane >> 5;
    LAS char* Kl = lds; LAS char* Vl = lds + 2 * SHM_T; volatile LAS int* flags = (volatile LAS int*)(lds + 4 * SHM_T);
    const int rw0 = t0 + 32 * wid, trow = rw0 + r32;
    const bf16* qp = proj + (size_t)trow * DIN + h * 128 + hi * 8;
    bf16x8 qr[8]; float qa = 0.f;
#pragma unroll
    for (int d0 = 0; d0 < 8; ++d0) { const u32x4 w = *(const u32x4*)(qp + d0 * 16); qr[d0] = __builtin_bit_cast(bf16x8, w);
        qa += fabsf(bf_lo(w.x)) + fabsf(bf_hi(w.x)) + fabsf(bf_lo(w.y)) + fabsf(bf_hi(w.y)) + fabsf(bf_lo(w.z)) + fabsf(bf_hi(w.z)) + fabsf(bf_lo(w.w)) + fabsf(bf_hi(w.w)); }
    qa += partner32(qa, hi);
    const float sthr = EXIT_THR + 1.01f * qa * kabs;
    const int sr = tid >> 4, sc = (tid & 15) * 8, vst0 = v_st(sr, sc), vst1 = v_st(32 + sr, sc), kst0 = SBA_KSWZ(sr, sc * 2), kst1 = SBA_KSWZ(32 + sr, sc * 2);
    const bf16* kg = proj + DSB + h * 128 + sc; const bf16* vg = proj + 2 * DSB + h * 128 + sc;
    const int vb0 = (int)(uintptr_t)Vl + v_rd_base(lane);
    f32x16 o[4] = {};
    float S = 0.f; bool wdone = false;
    u32x4 sk0, sk1, sv0, sv1;
#define SBA_SLOAD(kb) do { sk0 = *(const u32x4*)(kg + (size_t)((kb) + sr) * DIN); sk1 = *(const u32x4*)(kg + (size_t)((kb) + 32 + sr) * DIN); \
        sv0 = *(const u32x4*)(vg + (size_t)((kb) + sr) * DIN); sv1 = *(const u32x4*)(vg + (size_t)((kb) + 32 + sr) * DIN); } while (0)
#define SBA_SWRITE(b) do { *(LAS u32x4*)(Kl + (b) * SHM_T + kst0) = sk0; *(LAS u32x4*)(Kl + (b) * SHM_T + kst1) = sk1; \
        *(LAS u32x4*)(Vl + (b) * SHM_T + vst0) = sv0; *(LAS u32x4*)(Vl + (b) * SHM_T + vst1) = sv1; } while (0)
    const int jhi = (t0 >> 6) + 3;
    __syncthreads();
    SBA_SLOAD(jhi * 64); SBA_SWRITE(0); __syncthreads();
    int cur = 0;
    for (int j = jhi; j >= 0; --j) {
        const int kb = j * 64;
        if (j > 0) SBA_SLOAD(kb - 64);
        const bool active = !wdone && (kb < rw0 + 31);
        if (active) {
            f32x16 p0, p1;
            qkt(p0, p1, Kl + cur * SHM_T, qr, r32, hi);
            if (kb + 63 >= rw0) {
#pragma unroll
                for (int r = 0; r < 16; ++r) { const int key = kb + crow(r, hi); if (key >= trow) p0[r] = -1e30f; if (key + 32 >= trow) p1[r] = -1e30f; }
            }
            float x[32];
#pragma unroll
            for (int r = 0; r < 16; ++r) { x[r] = sp2(p0[r]); x[16 + r] = sp2(p1[r]); }
            float gs[8], og[8], a[8], R[8];
#pragma unroll
            for (int i = 0; i < 8; ++i) { x[4 * i + 2] += x[4 * i + 3]; x[4 * i + 1] += x[4 * i + 2]; x[4 * i] += x[4 * i + 1]; gs[i] = x[4 * i]; }
#pragma unroll
            for (int i = 0; i < 8; ++i) { og[i] = partner32(gs[i], hi); a[i] = gs[i] + og[i]; }
            R[7] = 0.f;
#pragma unroll
            for (int i = 6; i >= 0; --i) R[i] = R[i + 1] + a[i + 1];
            const float tot = R[0] + a[0];
#pragma unroll
            for (int i = 0; i < 8; ++i) { const float e = S + R[i] + (hi == 0 ? og[i] : 0.f);
#pragma unroll
                for (int q = 0; q < 4; ++q) { const int r = 4 * i + q; const float z = (r < 16) ? p0[r & 15] : p1[r & 15]; x[r] = __builtin_amdgcn_exp2f(z - x[r] - e); } }
            S += tot;
            bf16x8 pa0, pa1, pa2, pa3;
#define SBA_PK4(B0_, OUT) do { const unsigned a0 = cvt_pk_bf16(x[B0_ + 0], x[B0_ + 1]), a1 = cvt_pk_bf16(x[B0_ + 2], x[B0_ + 3]); \
        const unsigned b0 = cvt_pk_bf16(x[B0_ + 4], x[B0_ + 5]), b1 = cvt_pk_bf16(x[B0_ + 6], x[B0_ + 7]); \
        const auto r0 = __builtin_amdgcn_permlane32_swap(a0, b0, false, false); const auto r1 = __builtin_amdgcn_permlane32_swap(a1, b1, false, false); \
        const u32x4 w = {r0[0], r1[0], r0[1], r1[1]}; OUT = __builtin_bit_cast(bf16x8, w); } while (0)
            SBA_PK4(0, pa0); SBA_PK4(8, pa1); SBA_PK4(16, pa2); SBA_PK4(24, pa3);
#undef SBA_PK4
            const int vb = vb0 + cur * SHM_T;
            pv_one<0>(o[0], vb, pa0, pa1, pa2, pa3); pv_one<1>(o[1], vb, pa0, pa1, pa2, pa3); pv_one<2>(o[2], vb, pa0, pa1, pa2, pa3); pv_one<3>(o[3], vb, pa0, pa1, pa2, pa3);
            wdone = __all(S >= sthr);
        }
        if (lane == 0) flags[wid] = (wdone || j == 0) ? 1 : 0;
        __syncthreads();
        int alld = 1;
#pragma unroll
        for (int w = 0; w < NWAVES; ++w) alld &= flags[w];
        if (alld) break;
        SBA_SWRITE(cur ^ 1);
        __syncthreads();
        cur ^= 1;
    }
    bf16* op = out + (size_t)rw0 * DSB + h * 128 + r32;
#pragma unroll
    for (int r = 0; r < 16; ++r) { const int orow = crow(r, hi); float sq = 0.f;
#pragma unroll
        for (int d0 = 0; d0 < 4; ++d0) { const unsigned w = cvt_pk_bf16(o[d0][r], 0.f); op[(size_t)orow * DSB + d0 * 32] = (bf16)(w & 0xffffu); const float v = bf_lo(w); sq += v * v; }
        if (MERGE_FUSED) {
            sq += __shfl_xor(sq, 1); sq += __shfl_xor(sq, 2); sq += __shfl_xor(sq, 4); sq += __shfl_xor(sq, 8); sq += __shfl_xor(sq, 16);
            if (r32 == 0) __hip_atomic_fetch_add(ssrow + rw0 + orow, ss_fix(sq), RLX_AGENT); } }
#undef SBA_SLOAD
#undef SBA_SWRITE
}
}

__device__ __forceinline__ void ssm_state_item(const bf16* __restrict__ proj, const bf16* __restrict__ Wm, float* __restrict__ sst, const int g, const int ct, int lane) {
    asm volatile("" : "+v"(lane));
    const int cl = lane & 31, hh = lane >> 5, c = ct * 32 + cl;
    const bf16* up = proj + (size_t)(c * LCH) * DIN + 3 * DSB + 16 * g + 8 * hh;
    bf16x8 ub[16];
#pragma unroll
    for (int j = 0; j < 16; ++j) ub[j] = *(const bf16x8*)(up + (size_t)j * DIN);
    f32x16 acc[4];
#pragma unroll
    for (int rt = 0; rt < 4; ++rt) {
        acc[rt] = f32x16{};
        const bf16* wp = Wm + ((size_t)((g * 4 + rt) * 16) * 64 + lane) * 8;
        bf16x8 af[16];
#pragma unroll
        for (int ks = 0; ks < 16; ++ks) af[ks] = *(const bf16x8*)(wp + ks * 512);
        __builtin_amdgcn_sched_barrier(0);
#pragma unroll
        for (int ks = 0; ks < 16; ++ks) acc[rt] = __builtin_amdgcn_mfma_f32_32x32x16_bf16(af[ks], ub[ks], acc[rt], 0, 0, 0);
        __builtin_amdgcn_sched_barrier(0);
    }
#pragma unroll
    for (int rt = 0; rt < 4; ++rt)
#pragma unroll
        for (int r = 0; r < 16; ++r) sst[(size_t)(g * 128 + rt * 32 + sba::crow(r, hh)) * NCH + c] = acc[rt][r];
}
constexpr int SCAN_ITEMS = 256;
__device__ __forceinline__ void ssm_scan_item(float* __restrict__ sst, const f32x2* __restrict__ aux, const int it, LAS char* lds, const int tid_in) {
    int tid_ = tid_in; asm volatile("" : "+v"(tid_));
    const int tid = tid_, pr = tid >> 5, seg = tid & 31, q = it * 16 + pr, g = q >> 6, p = q & 63;
    float* re = sst + (size_t)(g * 128 + p) * NCH + seg * 32; float* im = re + (size_t)64 * NCH;
    const f32x2 A = aux[q]; const float ar = A.x, ai = A.y;
    LAS f32x2* ends = (LAS f32x2*)lds;
    f32x4 vr[8], vi[8];
#pragma unroll
    for (int i = 0; i < 8; ++i) { vr[i] = *(const f32x4*)(re + 4 * i); vi[i] = *(const f32x4*)(im + 4 * i); }
    float sr_ = 0.f, si_ = 0.f;
#pragma unroll
    for (int i = 0; i < 8; ++i)
#pragma unroll
        for (int k = 0; k < 4; ++k) { const float nr = ar * sr_ - ai * si_ + vr[i][k], ni = ar * si_ + ai * sr_ + vi[i][k]; sr_ = nr; si_ = ni; vr[i][k] = nr; vi[i][k] = ni; }
    __syncthreads();
    ends[pr * 32 + seg] = (f32x2){sr_, si_};
    __syncthreads();
    float br = ar, bi = ai;
#pragma unroll
    for (int k = 0; k < 5; ++k) { const float t = br * br - bi * bi; bi = 2.f * br * bi; br = t; }
    float cr = 0.f, ci = 0.f;
    for (int s = 0; s < seg; ++s) { const f32x2 e = ends[pr * 32 + s]; const float nr = br * cr - bi * ci + e.x, ni = br * ci + bi * cr + e.y; cr = nr; ci = ni; }
    float pr_ = ar, pi_ = ai;
#pragma unroll
    for (int i = 0; i < 8; ++i)
#pragma unroll
        for (int k = 0; k < 4; ++k) { vr[i][k] += pr_ * cr - pi_ * ci; vi[i][k] += pr_ * ci + pi_ * cr; const float t = pr_ * ar - pi_ * ai; pi_ = pr_ * ai + pi_ * ar; pr_ = t; }
#pragma unroll
    for (int i = 0; i < 8; ++i) { *(f32x4*)(re + 4 * i) = vr[i]; *(f32x4*)(im + 4 * i) = vi[i]; }
}
__device__ __forceinline__ void ssm_out_item(const bf16* __restrict__ proj, const bf16* __restrict__ TM, const float* __restrict__ sst, bf16* __restrict__ Y, const int g, const int ct, int lane) {
    asm volatile("" : "+v"(lane));
    const int cl = lane & 31, hh = lane >> 5, c = ct * 32 + cl;
    const bf16* up = proj + (size_t)(c * LCH) * DIN + 3 * DSB + 16 * g + 8 * hh;
    bf16x8 ub[16], sb[8];
#pragma unroll
    for (int j = 0; j < 16; ++j) ub[j] = *(const bf16x8*)(up + (size_t)j * DIN);
    const float* sp = sst + (size_t)(g * 128 + 8 * hh) * NCH + (c > 0 ? c - 1 : 0);
#pragma unroll
    for (int ks = 0; ks < 8; ++ks) { float v[8];
#pragma unroll
        for (int j = 0; j < 8; ++j) { const float t = sp[(size_t)(ks * 16 + j) * NCH]; v[j] = (c > 0) ? t : 0.f; }
        const u32x4 w = {cvt_pk_bf16(v[0], v[1]), cvt_pk_bf16(v[2], v[3]), cvt_pk_bf16(v[4], v[5]), cvt_pk_bf16(v[6], v[7])}; sb[ks] = __builtin_bit_cast(bf16x8, w); }
#pragma unroll
    for (int half = 0; half < 4; ++half) {
        f32x16 acc[2];
#pragma unroll
        for (int r4 = 0; r4 < 2; ++r4) { const int rt = half * 2 + r4;
            acc[r4] = f32x16{};
            const bf16* tp = TM + ((size_t)((g * 8 + rt) * 24) * 64 + lane) * 8;
            bf16x8 af[24];
#pragma unroll
            for (int j = 0; j < 16; ++j) if (j <= 2 * rt + 1) af[j] = *(const bf16x8*)(tp + j * 512);
#pragma unroll
            for (int ks = 0; ks < 8; ++ks) af[16 + ks] = *(const bf16x8*)(tp + (16 + ks) * 512);
            __builtin_amdgcn_sched_barrier(0);
#pragma unroll
            for (int j = 0; j < 16; ++j) if (j <= 2 * rt + 1) acc[r4] = __builtin_amdgcn_mfma_f32_32x32x16_bf16(af[j], ub[j], acc[r4], 0, 0, 0);
#pragma unroll
            for (int ks = 0; ks < 8; ++ks) acc[r4] = __builtin_amdgcn_mfma_f32_32x32x16_bf16(af[16 + ks], sb[ks], acc[r4], 0, 0, 0);
            __builtin_amdgcn_sched_barrier(0);
        }
#pragma unroll
        for (int r4 = 0; r4 < 2; ++r4) { const int rt = half * 2 + r4;
#pragma unroll
            for (int rg = 0; rg < 4; ++rg) { float v[4];
#pragma unroll
                for (int q = 0; q < 4; ++q) { const float xx = acc[r4][4 * rg + q]; const float u2 = 1.5957691216f * (xx + 0.044715f * xx * xx * xx); v[q] = xx * fast_sigmoid(u2); }
                const int t = c * LCH + 2 * rt + (rg >> 1), ch = 16 * g + 4 * hh + 8 * (rg & 1);
                const u32x2 w = {cvt_pk_bf16(v[0], v[1]), cvt_pk_bf16(v[2], v[3])};
                *(u32x2*)(Y + (size_t)t * DSSM + ch) = w; } }
    }
}

#define XB_TMO      128
#define XB_XCNT(j)  (256  + 64 * (j))
#define XB_XSUB(j)  (1280 + 64 * (j))
#define XB_XGEN(j)  (2304 + 64 * (j))
#define XB_TOP      3328
#define XB_TOPGEN   3392
#define XCD_BAR_WORDS 3456
#define XB_SPIN_CAP (1u << 20)
__device__ __forceinline__ unsigned xb_ld(unsigned* p)              { return __hip_atomic_load(p, __ATOMIC_RELAXED, __HIP_MEMORY_SCOPE_AGENT); }
__device__ __forceinline__ unsigned xb_add(unsigned* p, unsigned v) { return __hip_atomic_fetch_add(p, v, __ATOMIC_RELAXED, __HIP_MEMORY_SCOPE_AGENT); }
__device__ __forceinline__ unsigned xb_xcc_id() { return (unsigned)__builtin_amdgcn_s_getreg((3 << 11) | 20) & 0xFu; }
#define XB_SPIN(cond, bar) do { unsigned _sp = 0; while (cond) { __builtin_amdgcn_s_sleep(1); \
    if ((++_sp & 255u) == 0u) { if (xb_ld(&(bar)[XB_TMO])) break; if (_sp > XB_SPIN_CAP) { atomicAdd(&(bar)[XB_TMO], 1u); break; } } } } while (0)
struct XcdBarrier { unsigned* bar; unsigned x; volatile LAS unsigned* st; int wave; unsigned nwg; };
__device__ __forceinline__ bool xb_thread0(int wave) { return wave == 0 && lane_now() == 0; }
__device__ __forceinline__ XcdBarrier xcd_barrier_post(unsigned* bar, volatile LAS unsigned* st, int wave) {
    XcdBarrier b; b.bar = bar; b.x = xb_xcc_id(); b.st = st; b.wave = wave; b.nwg = 0u;
    if (xb_thread0(wave)) (void)xb_add(&bar[XB_XCNT(b.x)], 1u);
    return b;
}
__device__ __forceinline__ void xcd_barrier_complete(unsigned* bar, unsigned x, unsigned& nloc, unsigned& nx, const unsigned nwg) {
    const unsigned G = nwg ? nwg : gridDim.x * gridDim.y * gridDim.z;
    unsigned sum, cnt, mine, sp = 0u;
    for (;;) {
        sum = 0u; cnt = 0u; mine = 0u;
#pragma unroll
        for (unsigned j = 0; j < 16; ++j) { const unsigned c = xb_ld(&bar[XB_XCNT(j)]); sum += c; cnt += (c > 0u) ? 1u : 0u; mine = (j == x) ? c : mine; }
        if (sum == G) break;
        __builtin_amdgcn_s_sleep(1);
        if ((++sp & 255u) == 0u) { if (xb_ld(&bar[XB_TMO])) break; if (sp > XB_SPIN_CAP) { atomicAdd(&bar[XB_TMO], 1u); break; } }
    }
    nloc = mine > 0u ? mine : 1u; nx = cnt > 0u ? cnt : 1u;
}
__device__ __forceinline__ void xcd_barrier(const XcdBarrier& b_) {
    XcdBarrier b = b_; b.x = (unsigned)__builtin_amdgcn_readfirstlane((int)xb_xcc_id());
    asm volatile("s_waitcnt vmcnt(0)" ::: "memory");
    __syncthreads();
    if (xb_thread0(b.wave)) {
        unsigned* bar = b.bar;
        __builtin_amdgcn_s_waitcnt(0);
        unsigned nloc = b.st[0], nx = b.st[1];
        if (nloc == 0u) { xcd_barrier_complete(bar, b.x, nloc, nx, b.nwg); b.st[0] = nloc; b.st[1] = nx; }
        const unsigned old = xb_add(&bar[XB_XSUB(b.x)], 1u);
        const unsigned gen = old / nloc;
        if (old + 1u == (gen + 1u) * nloc) {
            __builtin_amdgcn_fence(__ATOMIC_RELEASE, "agent");
            asm volatile("s_waitcnt vmcnt(0)" ::: "memory");
            const unsigned og = xb_add(&bar[XB_TOP], 1u);
            const unsigned tg = og / nx;
            if (og + 1u == (tg + 1u) * nx) xb_add(&bar[XB_TOPGEN], 1u);
            else XB_SPIN(xb_ld(&bar[XB_TOPGEN]) == tg, bar);
            __builtin_amdgcn_fence(__ATOMIC_ACQUIRE, "agent");
            xb_add(&bar[XB_XGEN(b.x)], 1u);
            asm volatile("s_waitcnt vmcnt(0)" ::: "memory");
        } else {
            XB_SPIN(xb_ld(&bar[XB_XGEN(b.x)]) == gen, bar);
            __builtin_amdgcn_fence(__ATOMIC_ACQUIRE, "agent");
            asm volatile("s_waitcnt vmcnt(0)" ::: "memory");
        }
    }
    __syncthreads();
}

struct Params { const float* in[26]; float* out; unsigned char* ws; int ph_lo, ph_hi; };
enum { I_X = 0, I_APRE, I_APOST, I_FPRE, I_FPOST, I_WIN, I_LRE, I_LIM, I_LSTEP, I_BRE, I_BIM, I_CRE, I_CIM, I_SD, I_WGLU, I_BGLU, I_AON, I_SON, I_WOUT, I_FG, I_FU, I_FD, I_RT, I_MG, I_MU, I_MD };
struct Frame {
    LAS unsigned char* lds; GAS unsigned* ctl_; GAS unsigned char* ws_; const float* const* in; GAS float* out_;
    int tid, lane, wave, G, gw, NGW;
    __device__ __forceinline__ unsigned char* WS() const { return (unsigned char*)ws_; }
    __device__ __forceinline__ unsigned* CTL() const { return (unsigned*)ctl_; }
    __device__ __forceinline__ float* OUT() const { return (float*)out_; }
};

constexpr int CVT_P = 68;
constexpr int WIN8_NF = (16 - WIN8_TILES) * 256;
template <int SW>
__device__ __forceinline__ void cvt_load_tile(const float* __restrict__ W, const int N, const int k0, const int n0, const float* __restrict__ kg, LAS float* scr, const int lane) {
    const float* src = W + (size_t)(k0 + (lane >> 4)) * N + n0 + (lane & 15) * 4;
    f32x4 v[16];
#pragma unroll
    for (int i = 0; i < 16; ++i) v[i] = *(const f32x4*)(src + (size_t)(4 * i) * N);
    if (kg) {
#pragma unroll
        for (int i = 0; i < 16; ++i) v[i] = v[i] * kg[k0 + 4 * i + (lane >> 4)]; }
#pragma unroll
    for (int i = 0; i < 16; ++i) *(LAS f32x4*)(scr + (4 * i + (lane >> 4)) * CVT_P + (((lane & 15) * 4) ^ (SW == 1 ? 8 * (i >> 2) : 4 * (i >> 1)))) = v[i];
    LDS_WAIT(); asm volatile("" ::: "memory");
}
__device__ __forceinline__ void cvt_item(const float* __restrict__ W, const int K, const int N, bf16* __restrict__ WT, const int mode, const float scale, const int nscale, const float* __restrict__ kg, LAS float* scr, const int item, const int lane) {
    const int nblk = N >> 6, kb = item / nblk, nb = item - kb * nblk, k0 = kb << 6, n0 = nb << 6;
    cvt_load_tile<2>(W, N, k0, n0, kg, scr, lane);
    const int c = lane & 7;
    const float sc = (n0 < nscale) ? scale : 1.0f;
    const int drow0 = (mode == 0) ? n0 : ((n0 >> 7) * 256 + (n0 & 127) + (mode == 2 ? 128 : 0));
#pragma unroll
    for (int jj = 0; jj < 8; ++jj) { const int n = (lane >> 3) + 8 * jj; const LAS float* s = scr + (8 * c) * CVT_P + (n ^ (4 * c));
        u32x4 o; o.x = cvt_pk_bf16(s[0 * CVT_P] * sc, s[1 * CVT_P] * sc); o.y = cvt_pk_bf16(s[2 * CVT_P] * sc, s[3 * CVT_P] * sc); o.z = cvt_pk_bf16(s[4 * CVT_P] * sc, s[5 * CVT_P] * sc); o.w = cvt_pk_bf16(s[6 * CVT_P] * sc, s[7 * CVT_P] * sc);
        *(u32x4*)(WT + (size_t)(drow0 + n) * K + k0 + 8 * c) = o; }
    LDS_WAIT(); asm volatile("" ::: "memory");
}
__device__ __forceinline__ void cvt_item8(const float* __restrict__ W, const int K, const int N, unsigned char* __restrict__ WT, const int mode, const float* __restrict__ kg, LAS float* scr, const int item, const int lane, const float wm = 64.f) {
    const int nblk = N >> 6, kb = item / nblk, nb = item - kb * nblk, k0 = kb << 6, n0 = nb << 6;
    cvt_load_tile<1>(W, N, k0, n0, kg, scr, lane);
    const int c = lane & 3;
    const int drow0 = (mode == 0) ? n0 : ((n0 >> 7) * 256 + (n0 & 127) + (mode == 2 ? 128 : 0));
#pragma unroll
    for (int jj = 0; jj < 4; ++jj) { const int n = (lane >> 2) + 16 * jj; const LAS float* sp = scr + (16 * c) * CVT_P + (n ^ (8 * c));
        u32x4 o; o.x = cvt4_fp8(sp[0 * CVT_P] * wm, sp[1 * CVT_P] * wm, sp[2 * CVT_P] * wm, sp[3 * CVT_P] * wm); o.y = cvt4_fp8(sp[4 * CVT_P] * wm, sp[5 * CVT_P] * wm, sp[6 * CVT_P] * wm, sp[7 * CVT_P] * wm);
        o.z = cvt4_fp8(sp[8 * CVT_P] * wm, sp[9 * CVT_P] * wm, sp[10 * CVT_P] * wm, sp[11 * CVT_P] * wm); o.w = cvt4_fp8(sp[12 * CVT_P] * wm, sp[13 * CVT_P] * wm, sp[14 * CVT_P] * wm, sp[15 * CVT_P] * wm);
        *(u32x4*)(WT + (size_t)(drow0 + n) * K + k0 + 16 * c) = o; }
    LDS_WAIT(); asm volatile("" ::: "memory");
}
__device__ __forceinline__ void p0_weights(Frame& F) {
    asm volatile("" : "+v"(F.tid), "+v"(F.lane));
    LAS float* scr = (LAS float*)(F.lds + LDS_MAIN + F.wave * (64 * CVT_P * 4));
    constexpr int N_WIN = 4096, N_GLU = 256, N_WOUT = 2048, N_F = 6144, N_M = 3072;
    constexpr int B0 = 2 * N_WIN, B1 = B0 + 2 * N_GLU, B2 = B1 + 2 * N_WOUT, B3 = B2 + 3 * N_F;
    const int B4 = (SPEC_ATT > 0 && F.G == 256) ? B3 : B3 + 24 * N_M;
    const int B4a = (F.G == 256) ? (B4 / 100) * 94 : B4;
    for (int it0 = F.gw, second = 0;; ) {
        if (!second && it0 >= B4a) { if (F.G != 256 || (int)blockIdx.x < 128) break; second = 1; it0 = B4a + (F.gw - 128 * NWAVES); }
        if (second && it0 >= B4) break;
        const int it = it0; it0 += second ? (F.NGW - 128 * NWAVES) : F.NGW;
        int r = it;
        if (r < B0) { const int l = r / N_WIN; r -= l * N_WIN;
            if ((r % 64) / 4 >= 16 - WIN8_TILES) cvt_item8(F.in[I_WIN] + (size_t)l * DM * DIN, DM, DIN, F.WS() + WS_WIN + (size_t)l * DIN * DM * 2 + (size_t)WIN8_NF * DM, 0, F.in[I_APRE] + l * DM, scr, r, F.lane);
            else cvt_item(F.in[I_WIN] + (size_t)l * DM * DIN, DM, DIN, (bf16*)(F.WS() + WS_WIN) + (size_t)l * DIN * DM, 0, QSCALE, DSB, F.in[I_APRE] + l * DM, scr, r, F.lane);
            continue; }
        r -= B0;
        if (r < 2 * N_GLU) { const int l = r / N_GLU; r -= l * N_GLU;
            cvt_item(F.in[I_WGLU] + (size_t)l * DSSM * DSSM, DSSM, DSSM, (bf16*)(F.WS() + WS_WGLU) + (size_t)l * DSSM * DSSM, 0, 1.f, 0, nullptr, scr, r, F.lane); continue; }
        r -= 2 * N_GLU;
        if (r < 2 * N_WOUT) { const int l = r / N_WOUT; r -= l * N_WOUT;
            const float* kgo = !MERGE_FUSED ? nullptr : ((r / 64) < 16 ? F.in[I_AON] + l * DSB : F.in[I_SON] + l * DSSM - DSB);
            cvt_item(F.in[I_WOUT] + (size_t)l * DMIX * DM, DMIX, DM, (bf16*)(F.WS() + WS_WOUT) + (size_t)l * DM * DMIX, 0, 1.f, 0, kgo, scr, r, F.lane); continue; }
        r -= 2 * N_WOUT;
#if DENSE_GU_F8
        if (r < N_F) { if ((r % 96) / 2 < GU8_TILES) cvt_item8(F.in[I_FG], DM, DFF, F.WS() + WS_FGU, 1, F.in[I_FPRE], scr, r, F.lane, 64.f * GU8_WSCALE); else cvt_item(F.in[I_FG], DM, DFF, (bf16*)(F.WS() + WS_FGU), 1, 1.f, 0, F.in[I_FPRE], scr, r, F.lane); continue; }
        r -= N_F;
        if (r < N_F) { if ((r % 96) / 2 < GU8_TILES) cvt_item8(F.in[I_FU], DM, DFF, F.WS() + WS_FGU, 2, F.in[I_FPRE], scr, r, F.lane, 64.f * GU8_WSCALE); else cvt_item(F.in[I_FU], DM, DFF, (bf16*)(F.WS() + WS_FGU), 2, 1.f, 0, F.in[I_FPRE], scr, r, F.lane); continue; }
        r -= N_F;
#else
        if (r < N_F) { cvt_item(F.in[I_FG], DM, DFF, (bf16*)(F.WS() + WS_FGU), 1, 1.f, 0, F.in[I_FPRE], scr, r, F.lane); continue; }
        r -= N_F;
        if (r < N_F) { cvt_item(F.in[I_FU], DM, DFF, (bf16*)(F.WS() + WS_FGU), 2, 1.f, 0, F.in[I_FPRE], scr, r, F.lane); continue; }
        r -= N_F;
#endif
#if DENSE_DOWN_F8
        if (r < N_F) { cvt_item8(F.in[I_FD], DFF, DM, F.WS() + WS_FDN, 0, nullptr, scr, r, F.lane); continue; }
#else
        if (r < N_F) { cvt_item(F.in[I_FD], DFF, DM, (bf16*)(F.WS() + WS_FDN), 0, 1.f, 0, nullptr, scr, r, F.lane); continue; }
#endif
        r -= N_F;
        { const int m = r / (8 * N_M); r -= m * (8 * N_M); const int e = r / N_M; r -= e * N_M;
          if (m == 0) cvt_item8(F.in[I_MG] + (size_t)e * DM * DFE, DM, DFE, F.WS() + WS_MGU + (size_t)e * 2 * DFE * DM, 1, F.in[I_FPRE] + DM, scr, r, F.lane);
          else if (m == 1) cvt_item8(F.in[I_MU] + (size_t)e * DM * DFE, DM, DFE, F.WS() + WS_MGU + (size_t)e * 2 * DFE * DM, 2, F.in[I_FPRE] + DM, scr, r, F.lane);
          else cvt_item8(F.in[I_MD] + (size_t)e * DFE * DM, DFE, DM, F.WS() + WS_MDN + (size_t)e * DM * DFE, 0, nullptr, scr, r, F.lane); }
    }
}
struct MoeItem { const float* W; unsigned char* WT; const float* kg; int K, N, mode, k0, n0; };
__device__ __forceinline__ void moe_item(Frame& F, const int gi, MoeItem& d) {
    constexpr int N_M = 3072; int r = gi; const int m = r / (8 * N_M); r -= m * (8 * N_M); const int e = r / N_M; r -= e * N_M;
    if (m < 2) { d.W = (m == 0 ? F.in[I_MG] : F.in[I_MU]) + (size_t)e * DM * DFE; d.K = DM; d.N = DFE; d.WT = F.WS() + WS_MGU + (size_t)e * 2 * DFE * DM; d.mode = 1 + m; d.kg = F.in[I_FPRE] + DM; }
    else { d.W = F.in[I_MD] + (size_t)e * DFE * DM; d.K = DFE; d.N = DM; d.WT = F.WS() + WS_MDN + (size_t)e * DM * DFE; d.mode = 0; d.kg = nullptr; }
    const int nblk = d.N >> 6, kb = r / nblk, nb = r - kb * nblk; d.k0 = kb << 6; d.n0 = nb << 6;
}
__device__ __forceinline__ void p0_moe(Frame& F, const int hf, const int bx) {
    asm volatile("" : "+v"(F.tid), "+v"(F.lane));
    LAS float* scr = (LAS float*)(F.lds + LDS_MAIN + F.wave * (64 * CVT_P * 4));
    constexpr int HALF_ITEMS = 12 * 3072;
    const int step = (F.G - SPEC_ATT) * NWAVES, lane = F.lane;
    int it = (bx - SPEC_ATT) * NWAVES + F.wave;
    MoeItem cur, nxt; f32x4 v[16]; float g[16];
#define MOE_ISSUE(D) do { const float* src_ = (D).W + (size_t)((D).k0 + (lane >> 4)) * (D).N + (D).n0 + (lane & 15) * 4; const float* kg_ = (D).kg ? (D).kg : F.in[I_FPRE]; \
        _Pragma("unroll") for (int i = 0; i < 16; ++i) v[i] = *(const f32x4*)(src_ + (size_t)(4 * i) * (D).N); \
        _Pragma("unroll") for (int i = 0; i < 16; ++i) g[i] = kg_[(D).k0 + 4 * i + (lane >> 4)]; __builtin_amdgcn_sched_barrier(0); } while (0)
    if (it < HALF_ITEMS) { moe_item(F, hf * HALF_ITEMS + it, cur); MOE_ISSUE(cur); }
    while (it < HALF_ITEMS) {
        const bool hg = cur.kg != nullptr;
#pragma unroll
        for (int i = 0; i < 16; ++i) *(LAS f32x4*)(scr + (4 * i + (lane >> 4)) * CVT_P + (((lane & 15) * 4) ^ (8 * (i >> 2)))) = hg ? v[i] * g[i] : v[i];
        LDS_WAIT(); asm volatile("" ::: "memory");
        const int nit = it + step;
        if (nit < HALF_ITEMS) { moe_item(F, hf * HALF_ITEMS + nit, nxt); MOE_ISSUE(nxt); }
        { const int c = lane & 3; const int n0 = cur.n0, drow0 = (cur.mode == 0) ? n0 : ((n0 >> 7) * 256 + (n0 & 127) + (cur.mode == 2 ? 128 : 0));
#pragma unroll
          for (int jj = 0; jj < 4; ++jj) { const int n = (lane >> 2) + 16 * jj; const LAS float* sp = scr + (16 * c) * CVT_P + (n ^ (8 * c));
            u32x4 o; o.x = cvt4_fp8(sp[0 * CVT_P] * 64.f, sp[1 * CVT_P] * 64.f, sp[2 * CVT_P] * 64.f, sp[3 * CVT_P] * 64.f); o.y = cvt4_fp8(sp[4 * CVT_P] * 64.f, sp[5 * CVT_P] * 64.f, sp[6 * CVT_P] * 64.f, sp[7 * CVT_P] * 64.f);
            o.z = cvt4_fp8(sp[8 * CVT_P] * 64.f, sp[9 * CVT_P] * 64.f, sp[10 * CVT_P] * 64.f, sp[11 * CVT_P] * 64.f); o.w = cvt4_fp8(sp[12 * CVT_P] * 64.f, sp[13 * CVT_P] * 64.f, sp[14 * CVT_P] * 64.f, sp[15 * CVT_P] * 64.f);
            *(u32x4*)(cur.WT + (size_t)(drow0 + n) * cur.K + cur.k0 + 16 * c) = o; }
          LDS_WAIT(); asm volatile("" ::: "memory"); }
        cur = nxt; it = nit;
    }
#undef MOE_ISSUE
}
__device__ __forceinline__ void p0_ssm(Frame& F, const int l, const int g) {
    asm volatile("" : "+v"(F.tid), "+v"(F.lane));
    LAS f32x2* pw = (LAS f32x2*)(F.lds + LDS_MAIN);
    LAS f32x2* bb = pw + 17 * 64;
    LAS f32x2* cc = bb + 64 * 16;
    LAS f32x2* fl = cc + 16 * 64;
    LAS float* Kt = (LAS float*)(fl + 64);
    const int tid = F.tid;
    __syncthreads();
    for (int e = tid; e < 17 * 64; e += 512) { const int n = e >> 6, p = e & 63;
        const float lr = fminf(F.in[I_LRE][(l * NG + g) * SP + p], -1e-4f), li = F.in[I_LIM][(l * NG + g) * SP + p], dt = expf(F.in[I_LSTEP][l * NG + g]);
        const float mag = expf((float)n * dt * lr); float s, c; sincosf((float)n * dt * li, &s, &c); const f32x2 v = {mag * c, mag * s}; pw[e] = v;
        if (n == 16) ((f32x2*)(F.WS() + WS_SSMAUX))[(l * NG + g) * SP + p] = v; }
    if (tid < 64) { const int p = tid;
        const float lr = fminf(F.in[I_LRE][(l * NG + g) * SP + p], -1e-4f), li = F.in[I_LIM][(l * NG + g) * SP + p], dt = expf(F.in[I_LSTEP][l * NG + g]);
        float s1, c1, sh, ch; sincosf(dt * li, &s1, &c1); sincosf(0.5f * dt * li, &sh, &ch);
        const float em1 = expm1f(dt * lr), mag = em1 + 1.0f;
        const float nr = em1 * c1 - 2.0f * sh * sh, ni = mag * s1, den = lr * lr + li * li;
        fl[p] = (f32x2){(nr * lr + ni * li) / den, (ni * lr - nr * li) / den};
    }
    __syncthreads();
    for (int e = tid; e < 1024; e += 512) { const int p = e >> 4, h = e & 15; const size_t bi = ((size_t)(l * NG + g) * SP + p) * 16 + h;
        const float br = F.in[I_BRE][bi], bim = F.in[I_BIM][bi]; const f32x2 f = fl[p];
        bb[e] = (f32x2){f.x * br - f.y * bim, f.x * bim + f.y * br};
        const int h2 = e >> 6, p2 = e & 63; const size_t ci = ((size_t)(l * NG + g) * 16 + h2) * SP + p2;
        cc[e] = (f32x2){F.in[I_CRE][ci], F.in[I_CIM][ci]}; }
    __syncthreads();
    for (int e = tid; e < 4096; e += 512) { const int tau = e >> 8, h = (e >> 4) & 15, h2 = e & 15; float s = 0.f;
        for (int p = 0; p < 64; ++p) { const f32x2 a = pw[tau * 64 + p], b = bb[p * 16 + h2], c = cc[h * 64 + p];
            const float wr_ = a.x * b.x - a.y * b.y, wi_ = a.x * b.y + a.y * b.x; s += c.x * wr_ - c.y * wi_; }
        if (tau == 0 && h == h2) s += F.in[I_SD][l * DSSM + 16 * g + h];
        Kt[e] = s; }
    __syncthreads();
    bf16* Wm = (bf16*)(F.WS() + WS_SSMW) + (size_t)(l * NG + g) * 128 * 256;
    for (int q = tid; q < 4096; q += 512) { const int row = q >> 5, kk0 = (q & 31) * 8, j = kk0 >> 4, h0 = kk0 & 15, p = row & 63, isim = row >> 6; float v[8];
        const f32x2 a = pw[(15 - j) * 64 + p];
#pragma unroll
        for (int e = 0; e < 8; ++e) { const f32x2 b = bb[p * 16 + h0 + e]; v[e] = isim ? (a.x * b.y + a.y * b.x) : (a.x * b.x - a.y * b.y); }
        const u32x4 w = {cvt_pk_bf16(v[0], v[1]), cvt_pk_bf16(v[2], v[3]), cvt_pk_bf16(v[4], v[5]), cvt_pk_bf16(v[6], v[7])};
        *(u32x4*)(Wm + ((size_t)((row >> 5) * 16 + (kk0 >> 4)) * 64 + ((kk0 >> 3) & 1) * 32 + (row & 31)) * 8) = w; }
    bf16* TM = (bf16*)(F.WS() + WS_SSMTM) + (size_t)(l * NG + g) * 256 * 384;
    for (int q = tid; q < 256 * 48; q += 512) { const int row = q / 48, pk = q - row * 48, kk0 = pk * 8, i = row >> 4, h = row & 15; float v[8];
        if (kk0 < 256) { const int j = kk0 >> 4, h0 = kk0 & 15;
#pragma unroll
            for (int e = 0; e < 8; ++e) v[e] = (j <= i) ? Kt[((i - j) * 16 + h) * 16 + h0 + e] : 0.f;
        } else { const int sidx = kk0 - 256, isim = sidx >> 6, p0 = sidx & 63;
#pragma unroll
            for (int e = 0; e < 8; ++e) { const f32x2 c = cc[h * 64 + p0 + e], a = pw[(i + 1) * 64 + p0 + e]; v[e] = isim ? -(c.x * a.y + c.y * a.x) : (c.x * a.x - c.y * a.y); } }
        const u32x4 w = {cvt_pk_bf16(v[0], v[1]), cvt_pk_bf16(v[2], v[3]), cvt_pk_bf16(v[4], v[5]), cvt_pk_bf16(v[6], v[7])};
        *(u32x4*)(TM + ((size_t)((row >> 5) * 24 + (kk0 >> 4)) * 64 + ((kk0 >> 3) & 1) * 32 + (row & 31)) * 8) = w; }
    __syncthreads();
}

typedef __amdgpu_buffer_rsrc_t rsrc_t;
__device__ __forceinline__ rsrc_t mk_rsrc(const void* p, unsigned bytes) { return __builtin_amdgcn_make_buffer_rsrc(const_cast<void*>(p), 0, bytes, 0x00020000); }
__device__ __forceinline__ f32x4 bld_f4(rsrc_t r, int voff, int soff) { return __builtin_bit_cast(f32x4, __builtin_amdgcn_raw_buffer_load_b128(r, voff, soff, 0)); }
__device__ __forceinline__ u32x2 bld_u2(rsrc_t r, int voff, int soff) { return __builtin_amdgcn_raw_buffer_load_b64(r, voff, soff, 0); }
__device__ __forceinline__ void bst_f4(f32x4 v, rsrc_t r, int voff, int soff) { __builtin_amdgcn_raw_buffer_store_b128(__builtin_bit_cast(u32x4, v), r, voff, soff, 0); }
__device__ __forceinline__ void bst_u2(u32x2 v, rsrc_t r, int voff, int soff) { __builtin_amdgcn_raw_buffer_store_b64(v, r, voff, soff, 0); }
constexpr unsigned ROWF = DM * 4, ROWH = DM * 2;
__device__ __forceinline__ void pass_norm0(Frame& F) {
    asm volatile("" : "+v"(F.tid), "+v"(F.lane));
    const rsrc_t rx = mk_rsrc(F.in[I_X], (unsigned)T_ * ROWF), rn = mk_rsrc(F.WS() + WS_HN, (unsigned)T_ * ROWH), r8w = mk_rsrc(F.WS() + WS_H8W, (unsigned)T_ * DM);
    float* RS = (float*)(F.WS() + WS_RS);
    const int v16 = F.lane * 16, v8 = F.lane * 8;
    for (int row = F.gw; row < T_; row += F.NGW) {
        f32x4 v[16]; float ss = 0.f;
#pragma unroll
        for (int j = 0; j < 16; ++j) { v[j] = bld_f4(rx, v16, row * (int)ROWF + j * 1024); }
#pragma unroll
        for (int j = 0; j < 16; ++j) ss += v[j][0] * v[j][0] + v[j][1] * v[j][1] + v[j][2] * v[j][2] + v[j][3] * v[j][3];
        const float rs = rsqrtf(wave_sum(ss) * (1.0f / DM) + RMS_EPS);
#pragma unroll
        for (int j = 0; j < 16; ++j) { const u32x2 w = {cvt_pk_bf16(v[j][0], v[j][1]), cvt_pk_bf16(v[j][2], v[j][3])}; bst_u2(w, rn, v8, row * (int)ROWH + j * 512); }
        if (WIN8_TILES > 0) {
#pragma unroll
            for (int j = 0; j < 16; ++j) __builtin_amdgcn_raw_buffer_store_b32(cvt4_fp8(v[j][0], v[j][1], v[j][2], v[j][3]), r8w, F.lane * 4, row * DM + j * 256, 0); }
        if (F.lane == 0) RS[row] = rs;
    }
}
__device__ __forceinline__ void pass_merge(Frame& F, const int l) {
    asm volatile("" : "+v"(F.tid), "+v"(F.lane));
    const bf16* AO = (const bf16*)(F.WS() + WS_ATTO); const bf16* SO = (const bf16*)(F.WS() + WS_SSMO); bf16* MG = (bf16*)(F.WS() + WS_MERGED);
    for (int row = F.gw; row < T_; row += F.NGW) {
#pragma unroll
        for (int part = 0; part < 2; ++part) {
            const bf16* src = (part ? SO : AO) + (size_t)row * 1024 + 8 * F.lane; const float* gain = F.in[part ? I_SON : I_AON] + l * 1024 + 8 * F.lane;
            u32x4 w[2]; float v[16]; float ss = 0.f;
#pragma unroll
            for (int j = 0; j < 2; ++j) { w[j] = *(const u32x4*)(src + 512 * j);
                v[8 * j + 0] = bf_lo(w[j].x); v[8 * j + 1] = bf_hi(w[j].x); v[8 * j + 2] = bf_lo(w[j].y); v[8 * j + 3] = bf_hi(w[j].y);
                v[8 * j + 4] = bf_lo(w[j].z); v[8 * j + 5] = bf_hi(w[j].z); v[8 * j + 6] = bf_lo(w[j].w); v[8 * j + 7] = bf_hi(w[j].w); }
#pragma unroll
            for (int k = 0; k < 16; ++k) ss += v[k] * v[k];
            const float rs = rsqrtf(wave_sum(ss) * (1.0f / 1024.0f) + RMS_EPS);
            bf16* dst = MG + (size_t)row * DMIX + part * 1024 + 8 * F.lane;
#pragma unroll
            for (int j = 0; j < 2; ++j) { const f32x4 g0 = *(const f32x4*)(gain + 512 * j), g1 = *(const f32x4*)(gain + 512 * j + 4);
                const u32x4 o = {cvt_pk_bf16(v[8 * j + 0] * rs * g0[0], v[8 * j + 1] * rs * g0[1]), cvt_pk_bf16(v[8 * j + 2] * rs * g0[2], v[8 * j + 3] * rs * g0[3]),
                                 cvt_pk_bf16(v[8 * j + 4] * rs * g1[0], v[8 * j + 5] * rs * g1[1]), cvt_pk_bf16(v[8 * j + 6] * rs * g1[2], v[8 * j + 7] * rs * g1[3])};
                *(u32x4*)(dst + 512 * j) = o; }
        }
    }
}
__device__ __forceinline__ void pass_mix_row(Frame& F, const int l, const int dry, const u32x2 (&hw)[16], const u32x2 (&mv)[16], const int row,
                                             const rsrc_t rw, const rsrc_t r8, const rsrc_t rgp, float* RS, const int v16, const int v8) {

        f32x4 hv[16]; float ss = 0.f;
#pragma unroll
        for (int j = 0; j < 16; ++j) { const float a = bf_lo(mv[j].x), b = bf_hi(mv[j].x), c = bf_lo(mv[j].y), d = bf_hi(mv[j].y); ss += a * a + b * b + c * c + d * d; }
        const float rs = rsqrtf(wave_sum(ss) * (1.0f / DM) + RMS_EPS);
        float s2 = 0.f;
        float lg[8] = {0.f, 0.f, 0.f, 0.f, 0.f, 0.f, 0.f, 0.f};
#pragma unroll
        for (int j = 0; j < 16; ++j) { const f32x4 g = bld_f4(rgp, v16, j * 1024);
            hv[j][0] = bf_lo(hw[j].x) + bf_lo(mv[j].x) * rs * g[0]; hv[j][1] = bf_hi(hw[j].x) + bf_hi(mv[j].x) * rs * g[1]; hv[j][2] = bf_lo(hw[j].y) + bf_lo(mv[j].y) * rs * g[2]; hv[j][3] = bf_hi(hw[j].y) + bf_hi(mv[j].y) * rs * g[3];
            s2 += hv[j][0] * hv[j][0] + hv[j][1] * hv[j][1] + hv[j][2] * hv[j][2] + hv[j][3] * hv[j][3]; }
        const float rs2 = rsqrtf(wave_sum(s2) * (1.0f / DM) + RMS_EPS);
#pragma unroll
        for (int j = 0; j < 16; ++j) { const u32x2 w = {cvt_pk_bf16(hv[j][0], hv[j][1]), cvt_pk_bf16(hv[j][2], hv[j][3])}; bst_u2(w, rw, v8, row * (int)ROWH + j * 512); }
        if (F.lane == 0) RS[row + (dry ? T_ : 0)] = rs2;
        if (l == 1 || DENSE_GU_F8) {
#pragma unroll
            for (int j = 0; j < 16; ++j) { const float s8 = (l == 0) ? GU8_ASCALE : 1.0f; __builtin_amdgcn_raw_buffer_store_b32(cvt4_fp8(hv[j][0] * s8, hv[j][1] * s8, hv[j][2] * s8, hv[j][3] * s8), r8, F.lane * 4, row * DM + j * 256, 0); }
        }
        if (l == 1) {
#pragma unroll
            for (int j = 0; j < 16; ++j) {
                unsigned rjo = (unsigned)(j * 8192) + (unsigned)v16; asm volatile("" : "+v"(rjo));
                const LAS f32x4* rj = (const LAS f32x4*)(F.lds + LDS_MAIN + rjo);
#pragma unroll
                for (int i = 0; i < 4; ++i) { const f32x4 r0 = rj[(i * 2 + 0) * 64], r1 = rj[(i * 2 + 1) * 64]; const float hk = hv[j][i];
                    lg[0] += hk * r0[0]; lg[1] += hk * r0[1]; lg[2] += hk * r0[2]; lg[3] += hk * r0[3]; lg[4] += hk * r1[0]; lg[5] += hk * r1[1]; lg[6] += hk * r1[2]; lg[7] += hk * r1[3]; }
            }
#pragma unroll
            for (int e = 0; e < 8; ++e) lg[e] = wave_sum(lg[e]) * rs2;
            int e1 = 0; float l1 = lg[0];
#pragma unroll
            for (int e = 1; e < 8; ++e) if (lg[e] > l1) { l1 = lg[e]; e1 = e; }
            int e2 = -1; float l2 = -INFINITY;
#pragma unroll
            for (int e = 0; e < 8; ++e) if (e != e1 && (e2 < 0 || lg[e] > l2)) { l2 = lg[e]; e2 = e; }
            const float w = __expf(l2 - l1), g1 = 1.0f / (1.0f + w), g2 = w / (1.0f + w);
            if (F.lane == 0) {
                const int s1 = (int)__hip_atomic_fetch_add(F.CTL() + CW_CUR + 64 * e1, 1u, RLX_AGENT);
                const int sl2 = (int)__hip_atomic_fetch_add(F.CTL() + CW_CUR + 64 * e2, 1u, RLX_AGENT);
                i32x2* list = (i32x2*)(F.WS() + WS_LIST);
                list[(size_t)e1 * LIST_CAP + s1] = (i32x2){row, __float_as_int(g1)};
                list[(size_t)e2 * LIST_CAP + sl2] = (i32x2){row, __float_as_int(g2)};
                ((i32x4*)(F.WS() + WS_POS))[row] = (i32x4){e1, s1, e2, sl2};
            }
        }
}
__device__ __forceinline__ void pass_mix(Frame& F, const int l, const int dry = 0) {
    asm volatile("" : "+v"(F.tid), "+v"(F.lane));
    const float* gpre = F.in[I_FPRE] + l * DM;
    const rsrc_t rw = mk_rsrc(F.WS() + (dry ? WS_PROJ : WS_HN), (unsigned)T_ * ROWH);
    const rsrc_t rh = mk_rsrc(F.WS() + WS_HN, (unsigned)T_ * ROWH), rm = mk_rsrc(F.WS() + WS_MIXED, (unsigned)T_ * ROWH), r8 = mk_rsrc(F.WS() + WS_H8, (unsigned)T_ * DM);
    const rsrc_t rgp = mk_rsrc(F.in[I_APOST] + l * DM, ROWF);
    float* RS = (float*)(F.WS() + WS_RS);
    const int v16 = F.lane * 16, v8 = F.lane * 8;
    if (l == 1) {
        LAS f32x4* RL = (LAS f32x4*)(F.lds + LDS_MAIN);
        __syncthreads();
        for (int k = F.tid; k < DM; k += 512) { const int j = k >> 8, ln = (k & 255) >> 2, i = k & 3; const float g = gpre[k];
            const f32x4 r0 = *(const f32x4*)(F.in[I_RT] + (size_t)k * NE), r1 = *(const f32x4*)(F.in[I_RT] + (size_t)k * NE + 4);
            RL[((j * 4 + i) * 2 + 0) * 64 + ln] = r0 * g; RL[((j * 4 + i) * 2 + 1) * 64 + ln] = r1 * g; }
        __syncthreads();
    }
#define PM_LOAD(HW, MV, R) do { _Pragma("unroll") for (int j = 0; j < 16; ++j) { HW[j] = bld_u2(rh, v8, (R) * (int)ROWH + j * 512); MV[j] = bld_u2(rm, v8, (R) * (int)ROWH + j * 512); } __builtin_amdgcn_sched_barrier(0); } while (0)
    if (l == 0) {
        u32x2 hwA[16], mvA[16], hwB[16], mvB[16];
        if (F.gw < T_) PM_LOAD(hwA, mvA, F.gw);
        for (int row = F.gw; row < T_; row += 2 * F.NGW) {
            const int rowB = row + F.NGW, rowA2 = row + 2 * F.NGW;
            if (rowB < T_) PM_LOAD(hwB, mvB, rowB);
            pass_mix_row(F, 0, dry, hwA, mvA, row, rw, r8, rgp, RS, v16, v8);
            if (rowA2 < T_) PM_LOAD(hwA, mvA, rowA2);
            if (rowB < T_) pass_mix_row(F, 0, dry, hwB, mvB, rowB, rw, r8, rgp, RS, v16, v8);
        }
    } else {
        for (int row = F.gw; row < T_; row += F.NGW) { u32x2 hw[16], mv[16]; PM_LOAD(hw, mv, row); pass_mix_row(F, 1, dry, hw, mv, row, rw, r8, rgp, RS, v16, v8); }
    }
#undef PM_LOAD
}
constexpr int LDS_TAB = 131072;
__device__ __forceinline__ void moe_tiles(Frame& F, int (&ts)[9], int (&cnt)[8]) {
    int acc = 0;
#pragma unroll
    for (int e = 0; e < 8; ++e) { const int c = (int)__builtin_amdgcn_readfirstlane(__hip_atomic_load(F.CTL() + CW_CUR + 64 * e, RLX_AGENT)); cnt[e] = c; ts[e] = acc; acc += (c + 255) >> 8; }
    ts[8] = acc;
}
__device__ __forceinline__ int moe_build_table(Frame& F) {
    asm volatile("" : "+v"(F.tid), "+v"(F.lane));
    int ts[9], cnt[8]; moe_tiles(F, ts, cnt);
    LAS i32x4* tab = (LAS i32x4*)(F.lds + LDS_TAB);
    __syncthreads();
    for (int pm = F.tid; pm < ts[8]; pm += 512) { int e = 0;
#pragma unroll
        for (int k = 1; k < 8; ++k) e += (pm >= ts[k]) ? 1 : 0;
        int tse = 0, ce = 0;
#pragma unroll
        for (int k = 0; k < 8; ++k) { tse = (e == k) ? ts[k] : tse; ce = (e == k) ? cnt[k] : ce; }
        const int slot0 = (pm - tse) * 256, nv = ce - slot0; tab[pm] = (i32x4){e, slot0, nv < 256 ? nv : 256, 0}; }
    __syncthreads();
    return ts[8];
}
__device__ __forceinline__ void pass_ffn_row(Frame& F, const int l, const int dry, const u32x2 (&hw)[16], const u32x2 (&fa)[16], const u32x2 (&fb)[16], const int row,
                                             const rsrc_t rw, const rsrc_t ro, const rsrc_t rgp, float* RS, const int v16, const int v8, const rsrc_t r8w) {
    f32x4 fv[16]; float ss = 0.f;
#pragma unroll
    for (int j = 0; j < 16; ++j) {
        if (l == 0) fv[j] = (f32x4){bf_lo(fa[j].x), bf_hi(fa[j].x), bf_lo(fa[j].y), bf_hi(fa[j].y)};
        else if (MOE_Y8) {
            const auto a0 = __builtin_amdgcn_cvt_pk_f32_fp8((int)fa[j].x, false), a1 = __builtin_amdgcn_cvt_pk_f32_fp8((int)fa[j].x, true), b0 = __builtin_amdgcn_cvt_pk_f32_fp8((int)fb[j].x, false), b1 = __builtin_amdgcn_cvt_pk_f32_fp8((int)fb[j].x, true);
            fv[j] = (f32x4){(a0[0] + b0[0]) * 0.0625f, (a0[1] + b0[1]) * 0.0625f, (a1[0] + b1[0]) * 0.0625f, (a1[1] + b1[1]) * 0.0625f}; }
        else fv[j] = (f32x4){bf_lo(fa[j].x) + bf_lo(fb[j].x), bf_hi(fa[j].x) + bf_hi(fb[j].x), bf_lo(fa[j].y) + bf_lo(fb[j].y), bf_hi(fa[j].y) + bf_hi(fb[j].y)};
        ss += fv[j][0] * fv[j][0] + fv[j][1] * fv[j][1] + fv[j][2] * fv[j][2] + fv[j][3] * fv[j][3]; }
    const float rs = rsqrtf(wave_sum(ss) * (1.0f / DM) + RMS_EPS);
    float s2 = 0.f;
#pragma unroll
    for (int j = 0; j < 16; ++j) { const f32x4 g = bld_f4(rgp, v16, j * 1024);
        fv[j][0] = bf_lo(hw[j].x) + fv[j][0] * rs * g[0]; fv[j][1] = bf_hi(hw[j].x) + fv[j][1] * rs * g[1]; fv[j][2] = bf_lo(hw[j].y) + fv[j][2] * rs * g[2]; fv[j][3] = bf_hi(hw[j].y) + fv[j][3] * rs * g[3];
        s2 += fv[j][0] * fv[j][0] + fv[j][1] * fv[j][1] + fv[j][2] * fv[j][2] + fv[j][3] * fv[j][3]; }
    if (l == 0) {
        const float rs2 = rsqrtf(wave_sum(s2) * (1.0f / DM) + RMS_EPS);
#pragma unroll
        for (int j = 0; j < 16; ++j) { const u32x2 w = {cvt_pk_bf16(fv[j][0], fv[j][1]), cvt_pk_bf16(fv[j][2], fv[j][3])}; bst_u2(w, rw, v8, row * (int)ROWH + j * 512); }
        if (WIN8_TILES > 0) {
#pragma unroll
            for (int j = 0; j < 16; ++j) __builtin_amdgcn_raw_buffer_store_b32(cvt4_fp8(fv[j][0], fv[j][1], fv[j][2], fv[j][3]), r8w, F.lane * 4, row * DM + j * 256, 0); }
        if (F.lane == 0) RS[row + (dry ? T_ : 0)] = rs2;
    } else {
#pragma unroll
        for (int j = 0; j < 16; ++j) bst_f4(fv[j], ro, v16, row * (int)ROWF + j * 1024);
    }
}
__device__ __forceinline__ void pass_ffn(Frame& F, const int l, const int dry = 0) {
    asm volatile("" : "+v"(F.tid), "+v"(F.lane));
    const rsrc_t rw = mk_rsrc(F.WS() + (dry ? WS_PROJ : WS_HN), (unsigned)T_ * ROWH);
    const rsrc_t ro = mk_rsrc(F.OUT(), (unsigned)T_ * ROWF), rf = mk_rsrc(F.WS() + WS_MIXED, (unsigned)T_ * ROWH), ry = mk_rsrc(F.WS() + WS_YROWS, (unsigned)MOE_MAXROWS * (MOE_Y8 ? DM : ROWH)), rh = mk_rsrc(F.WS() + WS_HN, (unsigned)T_ * ROWH);
    const rsrc_t rgp = mk_rsrc(F.in[I_FPOST] + l * DM, ROWF), r8w = mk_rsrc(F.WS() + WS_H8W, (unsigned)T_ * DM);
    float* RS = (float*)(F.WS() + WS_RS);
    const int v16 = F.lane * 16, v8 = F.lane * 8;
    if (l == 0) {
#define PF_LOAD(HW, FA, R) do { _Pragma("unroll") for (int j = 0; j < 16; ++j) { HW[j] = bld_u2(rh, v8, (R) * (int)ROWH + j * 512); FA[j] = bld_u2(rf, v8, (R) * (int)ROWH + j * 512); } __builtin_amdgcn_sched_barrier(0); } while (0)
        u32x2 hwA[16], faA[16], hwB[16], faB[16];
        if (F.gw < T_) PF_LOAD(hwA, faA, F.gw);
        for (int row = F.gw; row < T_; row += 2 * F.NGW) {
            const int rowB = row + F.NGW, rowA2 = row + 2 * F.NGW;
            if (rowB < T_) PF_LOAD(hwB, faB, rowB);
            pass_ffn_row(F, 0, dry, hwA, faA, faA, row, rw, ro, rgp, RS, v16, v8, r8w);
            if (rowA2 < T_) PF_LOAD(hwA, faA, rowA2);
            if (rowB < T_) pass_ffn_row(F, 0, dry, hwB, faB, faB, rowB, rw, ro, rgp, RS, v16, v8, r8w);
        }
#undef PF_LOAD
    } else {
        int ts[9], cnt[8];
        moe_tiles(F, ts, cnt);
        const i32x4* POS = (const i32x4*)(F.WS() + WS_POS);
        i32x4 ps = (F.gw < T_) ? POS[F.gw] : (i32x4){0, 0, 0, 0};
        for (int row = F.gw; row < T_; row += F.NGW) {
            const int pe1 = __builtin_amdgcn_readfirstlane(ps.x), ps1 = __builtin_amdgcn_readfirstlane(ps.y), pe2 = __builtin_amdgcn_readfirstlane(ps.z), ps2 = __builtin_amdgcn_readfirstlane(ps.w);
            int t1 = 0, t2 = 0;
#pragma unroll
            for (int e = 0; e < 8; ++e) { t1 = (pe1 == e) ? ts[e] : t1; t2 = (pe2 == e) ? ts[e] : t2; }
            const int o1 = (t1 * 256 + ps1) * (int)(MOE_Y8 ? DM : ROWH), o2 = (t2 * 256 + ps2) * (int)(MOE_Y8 ? DM : ROWH);
            u32x2 hw[16], fa[16], fb[16];
#pragma unroll
            for (int j = 0; j < 16; ++j) { hw[j] = bld_u2(rh, v8, row * (int)ROWH + j * 512);
                if (MOE_Y8) { fa[j].x = (unsigned)__builtin_amdgcn_raw_buffer_load_b32(ry, F.lane * 4, o1 + j * 256, 0); fb[j].x = (unsigned)__builtin_amdgcn_raw_buffer_load_b32(ry, F.lane * 4, o2 + j * 256, 0); fa[j].y = 0u; fb[j].y = 0u; }
                else { fa[j] = bld_u2(ry, v8, o1 + j * 512); fb[j] = bld_u2(ry, v8, o2 + j * 512); } }
            const int nrow = row + F.NGW; if (nrow < T_) ps = POS[nrow];
            __builtin_amdgcn_sched_barrier(0);
            pass_ffn_row(F, 1, dry, hw, fa, fb, row, rw, ro, rgp, RS, v16, v8, r8w);
        }
    }
}

#ifndef REP_PRO
#define REP_PRO 1
#endif
#ifndef REP_GEMM
#define REP_GEMM 1
#endif
#ifndef REP_G0
#define REP_G0 1
#endif
#ifndef REP_G1
#define REP_G1 1
#endif
#ifndef REP_G2
#define REP_G2 1
#endif
#ifndef REP_G3
#define REP_G3 1
#endif
#ifndef REP_G4
#define REP_G4 1
#endif
#ifndef REP_N0
#define REP_N0 1
#endif
#ifndef REP_MIX
#define REP_MIX 1
#endif
#ifndef REP_ATT
#define REP_ATT 1
#endif
#ifndef REP_S1
#define REP_S1 1
#endif
#ifndef REP_S3
#define REP_S3 1
#endif
#ifndef PROBE_DRY
#define PROBE_DRY 0
#endif
constexpr int N_PHASES = 23;
#ifndef MK_LAUNCH_MODE
#define MK_LAUNCH_MODE 0
#endif
__global__ void __launch_bounds__(NWAVES * 64, 2) hymba_fwd(Params P) {
    extern __shared__ __attribute__((aligned(16))) unsigned char lds_raw[];
    Frame F;
    F.lds = (LAS unsigned char*)lds_raw; F.ws_ = (GAS unsigned char*)P.ws; F.ctl_ = (GAS unsigned*)(P.ws + WS_CTL); F.in = P.in; F.out_ = (GAS float*)P.out;
    F.tid = threadIdx.x; F.lane = F.tid & 63; F.wave = __builtin_amdgcn_readfirstlane(F.tid >> 6); F.G = gridDim.x;
    F.gw = blockIdx.x * NWAVES + F.wave; F.NGW = F.G * NWAVES;
    volatile LAS unsigned* MISC = (volatile LAS unsigned*)(F.lds + LDS_MISC);
    if (F.tid < 32) MISC[F.tid] = 0u;
    __syncthreads();
    const int lo = P.ph_lo, hi = P.ph_hi;
    XcdBarrier bar; bar.bar = F.CTL() + CW_BAR; bar.x = 0; bar.st = MISC + 8; bar.wave = F.wave; bar.nwg = 0u;
    XcdBarrier bar2 = bar; bar2.bar = F.CTL() + CW_BAR2; bar2.st = MISC + 10;
    if (SPEC_ATT > 0 && MK_LAUNCH_MODE == 0 && gridDim.x == 256 && (int)blockIdx.x < SPEC_ATT) { bar2 = xcd_barrier_post(F.CTL() + CW_BAR2, MISC + 10, F.wave); bar2.nwg = SPEC_ATT; }
    if (MK_LAUNCH_MODE == 0 || hi - lo > 1) bar = xcd_barrier_post(F.CTL() + CW_BAR, MISC + 8, F.wave);
#ifndef PHM
#define PHM 0xFFFFFFFFu
#endif
    constexpr bool ALL = (MK_LAUNCH_MODE == 0);
#define IN(k) (ALL || (lo <= (k) && (k) < hi))
#define SEAM(k) do { if (ALL ? ((k) + 1 < N_PHASES) : (IN(k) && IN((k) + 1))) xcd_barrier(bar); } while (0)
#define PHASE_FENCE() do { asm volatile("" : "+s"(F.ws_), "+s"(F.out_), "+s"(F.ctl_), "+s"(bx), "+s"(F.gw), "+s"(F.G), "+s"(F.NGW), "+s"(F.wave)); F.lane = lane_now(); F.tid = F.wave * 64 + F.lane; } while (0)
    LAS unsigned char* L0 = F.lds + LDS_MAIN;
    int bx = blockIdx.x;

    PHASE_FENCE();
    for (int rep = 0; rep < REP_PRO; ++rep) {
    if (rep) xcd_barrier(bar);
    if ((PHM & 1u) && IN(0)) {
        if (bx < 2 * NG) p0_ssm(F, bx >> 6, bx & 63);
        p0_weights(F);
        for (int rep = 0; rep < REP_N0; ++rep) pass_norm0(F);
    }
    }
    SEAM(0);
    for (int l = 0; l < 2; ++l) {
        const int pb = 1 + 11 * l;
#define HN ((bf16*)(F.WS() + WS_HN))
#define PROJ ((bf16*)(F.WS() + WS_PROJ))
#define ATTO ((bf16*)(F.WS() + WS_ATTO))
#define YB ((bf16*)(F.WS() + WS_Y))
#define SSMO ((bf16*)(F.WS() + WS_SSMO))
#define MERGED ((bf16*)(F.WS() + WS_MERGED))
#define MIXED ((bf16*)(F.WS() + WS_MIXED))
#define HID ((bf16*)(F.WS() + WS_HID))
#define SST ((float*)(F.WS() + WS_SST))
        PHASE_FENCE();
        for (int rep = 0; rep < REP_GEMM; ++rep) { if (rep) xcd_barrier(bar);
        if ((PHM & (1u << 1)) && IN(pb + 0)) {
            for (int rep_ = 0; rep_ < REP_G0; ++rep_) {
            { pg8::DenseOrder S; S.init(T_, WIN8_NF, DM, F.G, bx, HN, (const bf16*)(F.WS() + WS_WIN) + (size_t)l * DIN * DM);
              pg8::EpiStore E{PROJ, DIN, F.CTL() + CW_KMAX + 64 * l, 4, 8, (const float*)(F.WS() + WS_RS)};
              pg8::gemm_phase<pg8::EpiStore, pg8::DenseOrder, false>(L0, DM * 2, S, E, F.wave); }
            if (WIN8_TILES > 0) {
              pg8::DenseOrder S; S.init(T_, DIN - WIN8_NF, DM / 2, F.G, bx, F.WS() + WS_H8W, F.WS() + WS_WIN + (size_t)l * DIN * DM * 2 + (size_t)WIN8_NF * DM * 2);
              pg8::EpiStore E{PROJ + WIN8_NF, DIN, F.CTL() + CW_KMAX + 64 * l, 4 - (16 - WIN8_TILES), 8 - (16 - WIN8_TILES), (const float*)(F.WS() + WS_RS)};
              pg8::gemm_phase<pg8::EpiStore, pg8::DenseOrder, false, true>(L0, DM, S, E, F.wave); }
            }
        }
        }
        SEAM(pb + 0);
        for (int repm = 0; repm < REP_MIX; ++repm) { if (repm) xcd_barrier(bar);
        PHASE_FENCE();
        if ((PHM & (1u << 2)) && IN(pb + 1)) {
            const bool spec = SPEC_ATT > 0 && F.G == 256; const int na = spec ? SPEC_ATT : F.G;
            const bool scan_here = spec && ALL;
            if (spec && bx >= SPEC_ATT) p0_moe(F, l, bx); else {
            const float kabs = __uint_as_float(__hip_atomic_load(F.CTL() + CW_KMAX + 64 * l, RLX_AGENT)) * 1.01f;
            for (int rep = 0; rep < REP_ATT; ++rep)
            for (int u = bx; u < 64 * NH; u += na) sba::sb_unit(PROJ, ATTO, (u >> 3) * 256, u & 7, kabs, (LAS char*)L0, F.wave, (ssq_t*)(F.WS() + WS_SS) + (size_t)(2 * l) * T_);
            for (int rep = 0; rep < REP_S1; ++rep)
            for (int b = bx; b < 256; b += na) ssm_state_item(PROJ, (const bf16*)(F.WS() + WS_SSMW) + (size_t)l * NG * 128 * 256, SST, (b & 15) * 4 + (F.wave & 3), (b >> 4) * 2 + (F.wave >> 2), F.lane);
            if (scan_here) { xcd_barrier(bar2); PHASE_FENCE();
                for (int it = bx; it < SCAN_ITEMS; it += SPEC_ATT) ssm_scan_item(SST, (const f32x2*)(F.WS() + WS_SSMAUX) + l * NG * SP, it, (LAS char*)L0, F.tid); }
            }
        }
        SEAM(pb + 1);
        if (!(SPEC_ATT > 0 && F.G == 256 && ALL)) {
        PHASE_FENCE();
        if ((PHM & (1u << 3)) && IN(pb + 2)) { for (int it = bx; it < SCAN_ITEMS; it += F.G) ssm_scan_item(SST, (const f32x2*)(F.WS() + WS_SSMAUX) + l * NG * SP, it, (LAS char*)L0, F.tid); }
        SEAM(pb + 2);
        }
        PHASE_FENCE();
        if ((PHM & (1u << 4)) && IN(pb + 3)) { for (int rep = 0; rep < REP_S3; ++rep) for (int b = bx; b < 256; b += F.G) ssm_out_item(PROJ, (const bf16*)(F.WS() + WS_SSMTM) + (size_t)l * NG * 256 * 384, SST, YB, (b & 15) * 4 + (F.wave & 3), (b >> 4) * 2 + (F.wave >> 2), F.lane); }
        if (repm + 1 < REP_MIX) continue;
        SEAM(pb + 3);
        }
        PHASE_FENCE();
        for (int rep = 0; rep < REP_GEMM; ++rep) { if (rep) xcd_barrier(bar);
        if ((PHM & (1u << 5)) && IN(pb + 4)) {
            pg8::DenseOrder S; S.init(T_, DSSM, DSSM, F.G, bx, YB, (const bf16*)(F.WS() + WS_WGLU) + (size_t)l * DSSM * DSSM);
            pg8::EpiGLU E{SSMO, YB, DSSM, F.in[I_BGLU] + l * DSSM, (ssq_t*)(F.WS() + WS_SS) + (size_t)(2 * l + 1) * T_};
            for (int rep_ = 0; rep_ < REP_G1; ++rep_) pg8::gemm_phase<pg8::EpiGLU, pg8::DenseOrder, false>(L0, DSSM * 2, S, E, F.wave);
        }
        }
        SEAM(pb + 4);
        if (!MERGE_FUSED) {
        PHASE_FENCE();
        if ((PHM & (1u << 6)) && IN(pb + 5)) pass_merge(F, l);
        SEAM(pb + 5);
        }
        PHASE_FENCE();
        for (int rep = 0; rep < REP_GEMM; ++rep) { if (rep) xcd_barrier(bar);
        if ((PHM & (1u << 7)) && IN(pb + 6)) {
#if MERGE_FUSED
            pg8::DenseOrder S; S.init(T_, DM, DMIX, F.G, bx, ATTO, (const bf16*)(F.WS() + WS_WOUT) + (size_t)l * DM * DMIX); S.A2 = (const char*)SSMO; S.tstepA = (size_t)pg8::BM * DSB * 2;
            pg8::EpiStoreKS E{MIXED, DM, (const ssq_t*)(F.WS() + WS_SS) + (size_t)(2 * l) * T_, (const ssq_t*)(F.WS() + WS_SS) + (size_t)(2 * l + 1) * T_};
            for (int rep_ = 0; rep_ < REP_G2; ++rep_) pg8::gemm_phase<pg8::EpiStoreKS, pg8::DenseOrder, false>(L0, DMIX * 2, S, E, F.wave);
#else
            pg8::DenseOrder S; S.init(T_, DM, DMIX, F.G, bx, MERGED, (const bf16*)(F.WS() + WS_WOUT) + (size_t)l * DM * DMIX);
            pg8::EpiStore E{MIXED, DM, nullptr, 0, 0, nullptr};
            for (int rep_ = 0; rep_ < REP_G2; ++rep_) pg8::gemm_phase<pg8::EpiStore, pg8::DenseOrder, false>(L0, DMIX * 2, S, E, F.wave);
#endif
        }
        }
        SEAM(pb + 6);
        PHASE_FENCE();
        if ((PHM & (1u << 8)) && IN(pb + 7)) { if (PROBE_DRY && l == 0) { pass_mix(F, l, 1); xcd_barrier(bar); } pass_mix(F, l); }
        SEAM(pb + 7);
        PHASE_FENCE();
        for (int rep = 0; rep < REP_GEMM; ++rep) { if (rep) xcd_barrier(bar);
        if ((PHM & (1u << 9)) && IN(pb + 8)) {
            if (l == 0) {
#if DENSE_GU_F8
                for (int rep_ = 0; rep_ < REP_G3; ++rep_) {
                { pg8::DenseOrder S; S.init(T_, GU8_TILES * 256, DM / 2, F.G, bx, F.WS() + WS_H8, F.WS() + WS_FGU);
                  pg8::EpiSwiGLU8<true> E{(unsigned char*)HID, DFF, (const float*)(F.WS() + WS_RS), 1.0f / (GU8_ASCALE * GU8_WSCALE)};
                  pg8::gemm_phase<pg8::EpiSwiGLU8<true>, pg8::DenseOrder, false, true>(L0, DM, S, E, F.wave); }
                if (GU8_TILES < 48) { pg8::DenseOrder S; S.init(T_, (48 - GU8_TILES) * 256, DM, F.G, bx, HN, (const bf16*)(F.WS() + WS_FGU) + (size_t)GU8_TILES * 256 * DM);
                  pg8::EpiSwiGLU8<true> E{(unsigned char*)HID + GU8_TILES * 128, DFF, (const float*)(F.WS() + WS_RS)};
                  pg8::gemm_phase<pg8::EpiSwiGLU8<true>, pg8::DenseOrder, false>(L0, DM * 2, S, E, F.wave); }
                }
#elif DENSE_DOWN_F8
                pg8::DenseOrder S; S.init(T_, 2 * DFF, DM, F.G, bx, HN, (const bf16*)(F.WS() + WS_FGU));
                pg8::EpiSwiGLU8<true> E{(unsigned char*)HID, DFF, (const float*)(F.WS() + WS_RS)};
                for (int rep_ = 0; rep_ < REP_G3; ++rep_) pg8::gemm_phase<pg8::EpiSwiGLU8<true>, pg8::DenseOrder, false>(L0, DM * 2, S, E, F.wave);
#else
                pg8::DenseOrder S; S.init(T_, 2 * DFF, DM, F.G, bx, HN, (const bf16*)(F.WS() + WS_FGU));
                pg8::EpiSwiGLU E{HID, DFF, (const float*)(F.WS() + WS_RS)};
                for (int rep_ = 0; rep_ < REP_G3; ++rep_) pg8::gemm_phase<pg8::EpiSwiGLU, pg8::DenseOrder, false>(L0, DM * 2, S, E, F.wave);
#endif
            } else {
                pg8::MoeOrder S; S.nN = 2 * DFE / 256; S.G = F.G; S.c = bx; S.nM = moe_build_table(F); S.tab = (const LAS i32x4*)(F.lds + LDS_TAB);
                S.A = (const char*)(F.WS() + WS_H8); S.B = (const char*)(F.WS() + WS_MGU); S.tstepA = 0; S.tstepB = (size_t)256 * DM; S.estrideB = (size_t)2 * DFE * DM;
                S.list = (const i32x2*)(F.WS() + WS_LIST); S.gather = true;
                pg8::EpiSwiGLU8<false> E{(unsigned char*)HID, DFE, (const float*)(F.WS() + WS_RS)};
                for (int rep_ = 0; rep_ < REP_G3; ++rep_) pg8::gemm_phase<pg8::EpiSwiGLU8<false>, pg8::MoeOrder, true, true>(L0, DM, S, E, F.wave);
            }
        }
        }
        SEAM(pb + 8);
        PHASE_FENCE();
        for (int rep = 0; rep < REP_GEMM; ++rep) { if (rep) xcd_barrier(bar);
        if ((PHM & (1u << 10)) && IN(pb + 9)) {
            if (l == 0) {
                pg8::EpiStore E{MIXED, DM, nullptr, 0, 0, nullptr};
#if DENSE_DOWN_F8
                pg8::DenseOrder S; S.init(T_, DM, DFF / 2, F.G, bx, HID, (const bf16*)(F.WS() + WS_FDN));
                for (int rep_ = 0; rep_ < REP_G4; ++rep_) pg8::gemm_phase<pg8::EpiStore, pg8::DenseOrder, false, true>(L0, DFF, S, E, F.wave);
#else
                pg8::DenseOrder S; S.init(T_, DM, DFF, F.G, bx, HID, (const bf16*)(F.WS() + WS_FDN));
                for (int rep_ = 0; rep_ < REP_G4; ++rep_) pg8::gemm_phase<pg8::EpiStore, pg8::DenseOrder, false>(L0, DFF * 2, S, E, F.wave);
#endif
            } else {
                pg8::MoeOrder S; S.nN = DM / 256; S.G = F.G; S.c = bx; S.nM = moe_build_table(F); S.tab = (const LAS i32x4*)(F.lds + LDS_TAB);
                S.A = (const char*)HID; S.B = (const char*)(F.WS() + WS_MDN); S.tstepA = (size_t)256 * DFE; S.tstepB = (size_t)256 * DFE; S.estrideB = (size_t)DM * DFE;
                S.list = (const i32x2*)(F.WS() + WS_LIST); S.gather = false;
                pg8::EpiMoeDown E{(bf16*)(F.WS() + WS_YROWS), DM};
                for (int rep_ = 0; rep_ < REP_G4; ++rep_) pg8::gemm_phase<pg8::EpiMoeDown, pg8::MoeOrder, false, true>(L0, DFE, S, E, F.wave);
            }
        }
        }
        SEAM(pb + 9);
        PHASE_FENCE();
        if ((PHM & (1u << 11)) && IN(pb + 10)) { if (PROBE_DRY && l == 0) { pass_ffn(F, l, 1); xcd_barrier(bar); } pass_ffn(F, l); }
        SEAM(pb + 10);
    }
#undef IN
#undef SEAM
}

extern "C" void kernel_launch(void* const* d_in, const int* in_sizes, int n_in, void* d_out, int out_size, void* d_ws, size_t ws_size, hipStream_t stream) {
    static int grid = 0;
    if (grid == 0) {
        if (n_in != 26 || in_sizes[0] != T_ * DM || out_size != T_ * DM || ws_size < WS_END) {
            fprintf(stderr, "kernel_launch: shape/workspace mismatch (n_in %d, in0 %d, out %d, ws %zu < %zu); nothing launched\n", n_in, n_in > 0 ? in_sizes[0] : -1, out_size, ws_size, (size_t)WS_END); grid = -1; return; }
        int dev = 0, cus = 0, per_cu = 0;
        if (hipGetDevice(&dev) != hipSuccess || hipDeviceGetAttribute(&cus, hipDeviceAttributeMultiprocessorCount, dev) != hipSuccess) { fprintf(stderr, "kernel_launch: device query failed\n"); grid = -1; return; }
        if (hipFuncSetAttribute((const void*)hymba_fwd, hipFuncAttributeMaxDynamicSharedMemorySize, LDS_BYTES) != hipSuccess) { fprintf(stderr, "kernel_launch: hipFuncSetAttribute failed\n"); grid = -1; return; }
        if (hipOccupancyMaxActiveBlocksPerMultiprocessor(&per_cu, (const void*)hymba_fwd, NWAVES * 64, LDS_BYTES) != hipSuccess || per_cu < 1)
            fprintf(stderr, "kernel_launch: note: occupancy query reports %d workgroups per CU\n", per_cu);
        (void)hipGetLastError();
        grid = cus;
    }
    if (grid < 0) return;
    if (hipMemsetAsync((char*)d_ws + WS_CTL, 0, CTL_ZERO_BYTES, stream) != hipSuccess) { fprintf(stderr, "kernel_launch: memset failed\n"); return; }
    Params p{};
    for (int i = 0; i < 26; ++i) p.in[i] = (const float*)d_in[i];
    p.out = (float*)d_out; p.ws = (unsigned char*)d_ws;
#if MK_LAUNCH_MODE == 0
    p.ph_lo = 0; p.ph_hi = N_PHASES;
    hipLaunchKernelGGL(hymba_fwd, dim3(grid), dim3(NWAVES * 64), LDS_BYTES, stream, p);
#else
    for (int ph = 0; ph < N_PHASES; ++ph) { p.ph_lo = ph; p.ph_hi = ph + 1; hipLaunchKernelGGL(hymba_fwd, dim3(grid), dim3(NWAVES * 64), LDS_BYTES, stream, p); }
#endif
    const hipError_t le = hipPeekAtLastError();
    if (le != hipSuccess) fprintf(stderr, "kernel_launch: launch failed: %s\n", hipGetErrorName(le));
}
```
